# Optimizing an MI355X kernel written in HIP

```python
import jax, jax.numpy as jnp
from jax import lax
import numpy as np

D_MODEL = 1024
BATCH = 8
SEQ = 4096
DEPTH = 2

GRID_W = 64
CTX_LEN = 256

ATTN_HEADS = 8
ATTN_KV_HEADS = 2
Q_PER_KV = ATTN_HEADS // ATTN_KV_HEADS
HEAD_DIM = 64
ATTN_WIDTH = ATTN_HEADS * HEAD_DIM
KV_WIDTH = ATTN_KV_HEADS * HEAD_DIM
Q_BLOCK = 128
ROPE_THETA = 10000.0
ATTN_SCALE = HEAD_DIM ** -0.5

SSD_INNER = D_MODEL // 2
SSD_HEAD_DIM = 64
SSD_HEADS = SSD_INNER // SSD_HEAD_DIM
SSD_GROUPS = 2
SSD_STATE = 128
SSD_CONV = 5
SSD_CHUNK = 128
SSD_CONV_CH = SSD_INNER + 2 * SSD_GROUPS * SSD_STATE

CM_CH = D_MODEL // 2
CM_KERNEL = 31

N_BRANCH = 3
EPS = 1e-6

IN_SPLITS = (ATTN_WIDTH, KV_WIDTH, KV_WIDTH, ATTN_WIDTH,
             SSD_CONV_CH, 2 * SSD_HEADS, SSD_INNER,
             2 * CM_CH, CM_CH,
             N_BRANCH * D_MODEL)
IN_COLS = (2 * ATTN_WIDTH + 2 * KV_WIDTH + SSD_CONV_CH + 2 * SSD_HEADS + SSD_INNER
           + 3 * CM_CH + N_BRANCH * D_MODEL)

kernel_name = "hybrid_gated_attn_ssd_conformer_block"


def split_in(t):
    idx = []
    acc = 0
    for s in IN_SPLITS[:-1]:
        acc += s
        idx.append(acc)
    return jnp.split(t, idx, axis=-1)


def rmsnorm(x, w):
    xf = x.astype(jnp.float32)
    y = xf * lax.rsqrt(jnp.mean(xf * xf, axis=-1, keepdims=True) + EPS)
    return (y * w.astype(jnp.float32)).astype(x.dtype)


def layernorm(x, w, b):
    xf = x.astype(jnp.float32)
    mu = jnp.mean(xf, axis=-1, keepdims=True)
    d = xf - mu
    var = jnp.mean(d * d, axis=-1, keepdims=True)
    return (d * lax.rsqrt(var + EPS) * w.astype(jnp.float32) + b.astype(jnp.float32)).astype(x.dtype)


def depthwise_conv(x, w, b):
    k = w.shape[0]
    y = lax.conv_general_dilated(x, w[:, None, :].astype(x.dtype), window_strides=(1,),
                                 padding=[(k // 2, k // 2)],
                                 dimension_numbers=('NWC', 'WIO', 'NWC'),
                                 feature_group_count=x.shape[-1])
    return y + b


def axial_rope_tables(length):
    rows = length // GRID_W
    row = jnp.repeat(jnp.arange(rows), GRID_W).astype(jnp.float32)
    col = jnp.tile(jnp.arange(GRID_W), rows).astype(jnp.float32)
    n_freq = HEAD_DIM // 4
    inv = 1.0 / (ROPE_THETA ** (jnp.arange(n_freq, dtype=jnp.float32) / n_freq))
    ang_r = row[:, None] * inv
    ang_c = col[:, None] * inv
    return jnp.cos(ang_r), jnp.sin(ang_r), jnp.cos(ang_c), jnp.sin(ang_c)


def _rotate(x, cos, sin):
    x1, x2 = jnp.split(x, 2, axis=-1)
    return jnp.concatenate([x1 * cos - x2 * sin, x2 * cos + x1 * sin], axis=-1)


def apply_axial_rope(x, rope):
    cos_r, sin_r, cos_c, sin_c = rope
    xf = x.astype(jnp.float32)
    xr, xc = jnp.split(xf, 2, axis=-1)
    return jnp.concatenate([_rotate(xr, cos_r, sin_r), _rotate(xc, cos_c, sin_c)], axis=-1).astype(x.dtype)


def heads_q(t):
    b, l, _ = t.shape
    return t.reshape(b, l, ATTN_KV_HEADS, Q_PER_KV, HEAD_DIM).transpose(0, 2, 3, 1, 4)


def heads_kv(t):
    b, l, _ = t.shape
    return t.reshape(b, l, ATTN_KV_HEADS, HEAD_DIM).transpose(0, 2, 1, 3)


def merge_heads(o):
    b, kv, g, l, d = o.shape
    return o.transpose(0, 3, 1, 2, 4).reshape(b, l, kv * g * d)


def _attend(q, k, v):
    s = jnp.einsum('bkgqd,bksd->bkgqs', q, k).astype(jnp.float32) * ATTN_SCALE
    p = jax.nn.softmax(s, axis=-1).astype(v.dtype)
    return jnp.einsum('bkgqs,bksd->bkgqd', p, v)


def latent_attention(q, k, v, k_c, v_c):
    b, kv, g, l, d = q.shape
    nb = l // Q_BLOCK
    k_all = jnp.concatenate([k, k_c], axis=2)
    v_all = jnp.concatenate([v, v_c], axis=2)
    qb = q.reshape(b, kv, g, nb, Q_BLOCK, d).transpose(3, 0, 1, 2, 4, 5)
    ob = lax.map(lambda blk: _attend(blk, k_all, v_all), qb)
    return ob.transpose(1, 2, 3, 0, 4, 5).reshape(b, kv, g, l, d)


def segsum(x):
    t = x.shape[-1]
    xe = jnp.broadcast_to(x[..., :, None], x.shape + (t,))
    xs = jnp.cumsum(jnp.where(jnp.tril(jnp.ones((t, t), bool), -1), xe, 0.0), axis=-2)
    return jnp.where(jnp.tril(jnp.ones((t, t), bool)), xs, -jnp.inf)


def ssd_chunked(x, dt, a_head, bm, cm, init_state, with_output):
    b, l, h, p = x.shape
    n = bm.shape[-1]
    nc = l // SSD_CHUNK
    xd = (x * dt[..., None].astype(x.dtype)).reshape(b, nc, SSD_CHUNK, h, p)
    a = (dt * a_head).reshape(b, nc, SSD_CHUNK, h).transpose(0, 3, 1, 2)
    a_cum = jnp.cumsum(a, axis=-1)
    bc = bm.reshape(b, nc, SSD_CHUNK, h, n)
    cc = cm.reshape(b, nc, SSD_CHUNK, h, n)
    decay_states = jnp.exp(a_cum[..., -1:] - a_cum).astype(x.dtype)
    states = jnp.einsum('bclhn,bhcl,bclhp->bchpn', bc, decay_states, xd)
    states = jnp.concatenate([init_state[:, None].astype(x.dtype), states], axis=1)
    decay_chunk = jnp.exp(segsum(jnp.pad(a_cum[..., -1], ((0, 0), (0, 0), (1, 0))))).astype(x.dtype)
    new_states = jnp.einsum('bhzc,bchpn->bzhpn', decay_chunk, states)
    final_state = new_states[:, -1]
    if not with_output:
        return None, final_state
    states = new_states[:, :-1]
    lmat = jnp.exp(segsum(a)).astype(x.dtype)
    cb = jnp.einsum('bclhn,bcshn->bhcls', cc, bc)
    y_diag = jnp.einsum('bhcls,bcshp->bclhp', cb * lmat, xd)
    y_off = jnp.einsum('bclhn,bchpn,bhcl->bclhp', cc, states, jnp.exp(a_cum).astype(x.dtype))
    return (y_diag + y_off).reshape(b, l, h, p), final_state


def ssd_inputs(xbc, dt_raw, conv_w, conv_b, dt_bias):
    xbc = jax.nn.silu(depthwise_conv(xbc, conv_w, conv_b))
    b, l, _ = xbc.shape
    xs, bm, cm = jnp.split(xbc, [SSD_INNER, SSD_INNER + SSD_GROUPS * SSD_STATE], axis=-1)
    rep = SSD_HEADS // SSD_GROUPS
    xs = xs.reshape(b, l, SSD_HEADS, SSD_HEAD_DIM)
    bm = jnp.repeat(bm.reshape(b, l, SSD_GROUPS, SSD_STATE), rep, axis=2)
    cm = jnp.repeat(cm.reshape(b, l, SSD_GROUPS, SSD_STATE), rep, axis=2)
    dt = jax.nn.softplus(dt_raw.astype(jnp.float32).reshape(b, l, 2, SSD_HEADS)
                         + dt_bias.astype(jnp.float32))
    return xs, bm, cm, dt[:, :, 0], dt[:, :, 1]


def _flip(t):
    return jnp.flip(t, axis=1)


def bidir_ssd(xs, bm, cm, dt_f, dt_b, a, init_f, init_b, d_skip, with_output):
    y_f, s_f = ssd_chunked(xs, dt_f, a[0], bm, cm, init_f, with_output)
    y_b, s_b = ssd_chunked(_flip(xs), _flip(dt_b), a[1], _flip(bm), _flip(cm), init_b, with_output)
    if not with_output:
        return None, s_f, s_b
    y = y_f + _flip(y_b) + d_skip[:, None].astype(xs.dtype) * xs
    return y.reshape(xs.shape[0], xs.shape[1], SSD_INNER), s_f, s_b


def conformer_conv(glu, gate, conv_w, conv_b, ln_w, ln_b):
    u, g = jnp.split(glu, 2, axis=-1)
    v = u * jax.nn.sigmoid(g)
    v = depthwise_conv(v, conv_w, conv_b)
    v = jax.nn.silu(layernorm(v, ln_w, ln_b))
    return v * jax.nn.silu(gate)


def gated_merge(ua, us, uc, gm, w_br_attn, w_br_ssd, w_br_conv, b_gate, w_out):
    g = jax.nn.sigmoid(gm.reshape(gm.shape[:-1] + (N_BRANCH, D_MODEL)) + b_gate)
    y = (g[..., 0, :] * (ua @ w_br_attn) + g[..., 1, :] * (us @ w_br_ssd)
         + g[..., 2, :] * (uc @ w_br_conv))
    return y @ w_out


def hybrid_layer(x, xc, c, c_ctx, w_mod, b_mod, norm_w, w_in, q_norm_w, k_norm_w,
                 ssd_conv_w, ssd_conv_b, ssd_A_log, ssd_dt_bias, ssd_D, ssd_norm_w,
                 cm_conv_w, cm_conv_b, cm_ln_w, cm_ln_b,
                 w_br_attn, w_br_ssd, w_br_conv, b_gate, w_out, rope, last):
    b = x.shape[0]
    mod = jax.nn.silu(c) @ w_mod + b_mod
    mod_c = jax.nn.silu(c_ctx) @ w_mod + b_mod
    shift, scale, gate = jnp.split(mod[:, None, :], 3, axis=-1)
    shift_c, scale_c, gate_c = jnp.split(mod_c, 3, axis=-1)
    h = rmsnorm(x, norm_w) * (1.0 + scale) + shift
    hc = rmsnorm(xc, norm_w) * (1.0 + scale_c) + shift_c

    q, k, v, ga, xbc, dt, z, glu, gcv, gm = split_in(h @ w_in)
    if last:
        w_parts = split_in(w_in)
        k_c, v_c, xbc_c, dt_c = (hc @ w_parts[1], hc @ w_parts[2], hc @ w_parts[4], hc @ w_parts[5])
    else:
        q_c, k_c, v_c, ga_c, xbc_c, dt_c, z_c, glu_c, gcv_c, gm_c = split_in(hc @ w_in)

    qh = apply_axial_rope(rmsnorm(heads_q(q), q_norm_w), rope)
    kh = apply_axial_rope(rmsnorm(heads_kv(k), k_norm_w), rope)
    kh_c = rmsnorm(heads_kv(k_c), k_norm_w)
    vh_c = heads_kv(v_c)
    ua = merge_heads(latent_attention(qh, kh, heads_kv(v), kh_c, vh_c)) * jax.nn.silu(ga)

    a = -jnp.exp(ssd_A_log.astype(jnp.float32))
    xs_c, bm_c, cm_c, dtf_c, dtb_c = ssd_inputs(xbc_c, dt_c, ssd_conv_w, ssd_conv_b, ssd_dt_bias)
    zero = jnp.zeros((b, SSD_HEADS, SSD_HEAD_DIM, SSD_STATE), xs_c.dtype)
    yc, s_f, s_b = bidir_ssd(xs_c, bm_c, cm_c, dtf_c, dtb_c, a, zero, zero, ssd_D, not last)
    xs, bm, cm, dtf, dtb = ssd_inputs(xbc, dt, ssd_conv_w, ssd_conv_b, ssd_dt_bias)
    y, _, _ = bidir_ssd(xs, bm, cm, dtf, dtb, a, s_f, s_b, ssd_D, True)
    us = rmsnorm(y * jax.nn.silu(z), ssd_norm_w)

    uc = conformer_conv(glu, gcv, cm_conv_w, cm_conv_b, cm_ln_w, cm_ln_b)

    out = gated_merge(ua, us, uc, gm, w_br_attn, w_br_ssd, w_br_conv, b_gate, w_out)
    x_new = x + gate * out
    if last:
        return x_new, None

    qh_c = rmsnorm(heads_q(q_c), q_norm_w)
    ua_c = merge_heads(_attend(qh_c, kh_c, vh_c)) * jax.nn.silu(ga_c)
    us_c = rmsnorm(yc * jax.nn.silu(z_c), ssd_norm_w)
    uc_c = conformer_conv(glu_c, gcv_c, cm_conv_w, cm_conv_b, cm_ln_w, cm_ln_b)
    out_c = gated_merge(ua_c, us_c, uc_c, gm_c, w_br_attn, w_br_ssd, w_br_conv, b_gate, w_out)
    return x_new, xc + gate_c * out_c


def setup_inputs(seed: int = 0) -> dict:
    key = jax.random.key(seed)
    ks = jax.random.split(key, 32)
    f32 = jnp.float32

    def nrm(k, shape, s):
        return jax.random.normal(k, shape, f32) * s

    def gain(k, shape):
        return 1.0 + 0.05 * jax.random.normal(k, shape, f32)

    dt0 = jnp.exp(jax.random.uniform(ks[10], (DEPTH, 2, SSD_HEADS), f32,
                                     math_log(0.001), math_log(0.1)))
    return {
        'x': nrm(ks[0], (BATCH, SEQ, D_MODEL), 1.0),
        'c': nrm(ks[1], (BATCH, D_MODEL), 1.0),
        'ctx': nrm(ks[2], (BATCH, CTX_LEN, D_MODEL), 1.0),
        'c_ctx': nrm(ks[3], (D_MODEL,), 1.0),
        'w_mod': nrm(ks[4], (DEPTH, D_MODEL, 3 * D_MODEL), 0.5 * D_MODEL ** -0.5),
        'b_mod': nrm(ks[5], (DEPTH, 3 * D_MODEL), 0.01),
        'norm_w': gain(ks[6], (DEPTH, D_MODEL)),
        'w_in': nrm(ks[7], (DEPTH, D_MODEL, IN_COLS), D_MODEL ** -0.5),
        'q_norm_w': gain(ks[8], (DEPTH, HEAD_DIM)),
        'k_norm_w': gain(ks[9], (DEPTH, HEAD_DIM)),
        'ssd_conv_w': nrm(ks[11], (DEPTH, SSD_CONV, SSD_CONV_CH), SSD_CONV ** -0.5),
        'ssd_conv_b': nrm(ks[12], (DEPTH, SSD_CONV_CH), 0.02),
        'ssd_A_log': jnp.log(jax.random.uniform(ks[13], (DEPTH, 2, SSD_HEADS), f32, 1.0, 16.0)),
        'ssd_dt_bias': dt0 + jnp.log(-jnp.expm1(-dt0)),
        'ssd_D': gain(ks[14], (DEPTH, SSD_HEADS)),
        'ssd_norm_w': gain(ks[15], (DEPTH, SSD_INNER)),
        'cm_conv_w': nrm(ks[16], (DEPTH, CM_KERNEL, CM_CH), CM_KERNEL ** -0.5),
        'cm_conv_b': nrm(ks[17], (DEPTH, CM_CH), 0.02),
        'cm_ln_w': gain(ks[18], (DEPTH, CM_CH)),
        'cm_ln_b': nrm(ks[19], (DEPTH, CM_CH), 0.02),
        'w_br_attn': nrm(ks[20], (DEPTH, ATTN_WIDTH, D_MODEL), ATTN_WIDTH ** -0.5),
        'w_br_ssd': nrm(ks[21], (DEPTH, SSD_INNER, D_MODEL), SSD_INNER ** -0.5),
        'w_br_conv': nrm(ks[22], (DEPTH, CM_CH, D_MODEL), CM_CH ** -0.5),
        'b_gate': nrm(ks[23], (DEPTH, N_BRANCH, D_MODEL), 0.1),
        'w_out': nrm(ks[24], (DEPTH, D_MODEL, D_MODEL), D_MODEL ** -0.5),
        'final_norm_w': gain(ks[25], (D_MODEL,)),
    }


def math_log(v):
    return float(np.log(v))


def reference(x, c, ctx, c_ctx, w_mod, b_mod, norm_w, w_in, q_norm_w, k_norm_w,
              ssd_conv_w, ssd_conv_b, ssd_A_log, ssd_dt_bias, ssd_D, ssd_norm_w,
              cm_conv_w, cm_conv_b, cm_ln_w, cm_ln_b,
              w_br_attn, w_br_ssd, w_br_conv, b_gate, w_out, final_norm_w):
    rope = axial_rope_tables(x.shape[1])
    xc = ctx
    for i in range(DEPTH):
        x, xc = hybrid_layer(x, xc, c, c_ctx, w_mod[i], b_mod[i], norm_w[i], w_in[i],
                             q_norm_w[i], k_norm_w[i], ssd_conv_w[i], ssd_conv_b[i],
                             ssd_A_log[i], ssd_dt_bias[i], ssd_D[i], ssd_norm_w[i],
                             cm_conv_w[i], cm_conv_b[i], cm_ln_w[i], cm_ln_b[i],
                             w_br_attn[i], w_br_ssd[i], w_br_conv[i], b_gate[i], w_out[i],
                             rope, i == DEPTH - 1)
    return rmsnorm(x, final_norm_w)
```

```cpp
#include <hip/hip_runtime.h>
#include <hip/hip_cooperative_groups.h>
namespace cg = cooperative_groups;

#define DI __device__ __forceinline__
typedef unsigned short bfu;
typedef __attribute__((ext_vector_type(8))) short bf16x8;
typedef __attribute__((ext_vector_type(4))) float f32x4;
typedef __attribute__((ext_vector_type(4))) unsigned u32x4;
typedef __attribute__((ext_vector_type(2))) unsigned u32x2;

constexpr int DM = 1024;
constexpr int NLAT = 32768;
constexpr int NROWS = 34816;
constexpr int PS = 4352;
constexpr int INC = 7440;
constexpr int PC_Q = 0, PC_K = 512, PC_V = 640, PC_GA = 768, PC_XBC = 1280, PC_Z = 2304,
              PC_GLU = 2816, PC_GCV = 3840;
constexpr int NKEY = 4352;
constexpr float EPS = 1e-6f;
constexpr float QSCALE = 0.125f * 1.4426950408889634f;
constexpr float LOG2E = 1.4426950408889634f;
constexpr int NSLOT = 34;
#ifndef REP
#define REP 0
#endif
#ifndef KNOCK
#define KNOCK 0
#endif

constexpr size_t OFF_WIN = 0;
constexpr size_t SZ_WIN = (size_t)2 * 4480 * 1024 * 2;
constexpr size_t OFF_WG = OFF_WIN + SZ_WIN;
constexpr size_t SZ_WG = (size_t)2 * 3072 * 1024 * 2;
constexpr size_t OFF_WBR = OFF_WG + SZ_WG;
constexpr size_t SZ_WBR = (size_t)2 * 3 * 1024 * 512 * 2;
constexpr size_t OFF_WOUT = OFF_WBR + SZ_WBR;
constexpr size_t SZ_WOUT = (size_t)2 * 1024 * 1024 * 2;
constexpr size_t OFF_MOD = OFF_WOUT + SZ_WOUT;
constexpr size_t SZ_MOD = (size_t)2 * 9 * 3072 * 4;
constexpr size_t OFF_H = OFF_MOD + SZ_MOD;
constexpr size_t SZ_H = (size_t)NROWS * 1024 * 2;
constexpr size_t OFF_P = OFF_H + SZ_H;
constexpr size_t SZ_P = (size_t)NROWS * PS * 2;
constexpr size_t OFF_DT = OFF_P + SZ_P;
constexpr size_t SZ_DT = (size_t)NROWS * 16 * 4;
constexpr size_t OFF_KP = OFF_DT + SZ_DT;
constexpr size_t SZ_KP = (size_t)8 * 2 * NKEY * 64 * 2;
constexpr size_t OFF_VT = OFF_KP + SZ_KP;
constexpr size_t OFF_ST = OFF_VT + SZ_KP;
constexpr size_t SZ_ST = (size_t)8 * 2 * NSLOT * 8 * 8192 * 2;
constexpr size_t OFF_DEC = OFF_ST + SZ_ST;
constexpr size_t SZ_DEC = (size_t)8 * 2 * NSLOT * 8 * 4;
constexpr size_t OFF_SS = OFF_DEC + SZ_DEC;
constexpr size_t SZ_SS = (size_t)NROWS * 8 * 4;
constexpr size_t OFF_X1C = OFF_SS + SZ_SS;
constexpr size_t SZ_X1C = (size_t)2048 * 1024 * 4;
constexpr size_t OFF_BT = OFF_X1C + SZ_X1C;
constexpr size_t SZ_BT = (size_t)256 * NROWS * 2;
constexpr size_t OFF_BAR = OFF_BT + SZ_BT;
constexpr size_t SZ_BAR = (size_t)3456 * 4;
constexpr size_t OFF_ROPE = OFF_BAR + ((SZ_BAR + 255) / 256) * 256;
constexpr size_t SZ_ROPE = (size_t)64 * 16 * 2 * 4;
constexpr size_t WS_TOTAL = OFF_ROPE + SZ_ROPE;
static_assert(WS_TOTAL <= (size_t)512 * 1024 * 1024, "workspace too large");
static_assert(SZ_ST == (size_t)NROWS * 1024 * 2, "ybuf alias size");

struct Params {
  const float *x, *c, *ctx, *c_ctx, *w_mod, *b_mod, *norm_w, *w_in, *q_norm_w, *k_norm_w;
  const float *ssd_conv_w, *ssd_conv_b, *ssd_A_log, *ssd_dt_bias, *ssd_D, *ssd_norm_w;
  const float *cm_conv_w, *cm_conv_b, *cm_ln_w, *cm_ln_b;
  const float *w_br[3];
  const float *b_gate, *w_out, *final_norm_w;
  float* out;
  char* ws;
};

DI char* ows(const Params& p) {
  const unsigned long long v = (unsigned long long)p.ws;
  unsigned lo = __builtin_amdgcn_readfirstlane((unsigned)v), hi = __builtin_amdgcn_readfirstlane((unsigned)(v >> 32));
  asm volatile("" : "+s"(lo), "+s"(hi));
  return (char*)(((unsigned long long)hi << 32) | lo);
}
DI bfu f2bf(float x) { unsigned u = __float_as_uint(x); u += 0x7fffu + ((u >> 16) & 1u); return (bfu)(u >> 16); }
DI float bf2f(unsigned b) { return __uint_as_float(b << 16); }
typedef __bf16 hbf16x2 __attribute__((ext_vector_type(2)));
typedef float f32x2 __attribute__((ext_vector_type(2)));
DI unsigned pack2(float a, float b) { f32x2 v = {a, b}; return __builtin_bit_cast(unsigned, __builtin_convertvector(v, hbf16x2)); }
DI float lo_f(unsigned w) { return __uint_as_float(w << 16); }
DI float hi_f(unsigned w) { return __uint_as_float(w & 0xffff0000u); }
DI float fexp2(float x) { return __builtin_amdgcn_exp2f(x); }
DI float fexp(float x) { return __builtin_amdgcn_exp2f(x * LOG2E); }
DI float frcp(float x) { return __builtin_amdgcn_rcpf(x); }
DI float sigmoidf_(float x) { return frcp(1.f + fexp(-x)); }
DI float siluf_(float x) { return x * sigmoidf_(x); }
DI f32x4 mfma16(bf16x8 a, bf16x8 b, f32x4 c) { return __builtin_amdgcn_mfma_f32_16x16x32_bf16(a, b, c, 0, 0, 0); }
DI bf16x8 as_bf8(u32x4 v) { return __builtin_bit_cast(bf16x8, v); }
DI float wave_sum(float v) {
#pragma unroll
  for (int o = 32; o >= 1; o >>= 1) v += __shfl_xor(v, o);
  return v;
}
DI int swz(int row) { return (-(row >> 2)) & 3; }
DI int otid() { int t = threadIdx.x; asm volatile("" : "+v"(t)); return t; }

DI void cvt_tile(const float* __restrict__ src, int src_ld, int src_col0, int nvalid, int k0,
                 bfu* __restrict__ dst, int dst_ld, const float* __restrict__ kscale, float* lds, int src_col1 = -1) {
  const int tid = otid();
  const int c = tid & 63, r0 = tid >> 6;
  const int scol = (src_col1 >= 0 && c >= 32) ? src_col1 + (c - 32) : src_col0 + c;
  float tv[16];
#pragma unroll
  for (int i = 0; i < 16; ++i) {
    const int kk = r0 + i * 4;
    tv[i] = (c < nvalid) ? src[(size_t)(k0 + kk) * src_ld + scol] : 0.f;
  }
#pragma unroll
  for (int i = 0; i < 16; ++i) {
    const int kk = r0 + i * 4;
    float v = tv[i];
    if (kscale) v *= kscale[k0 + kk];
    lds[c * 65 + kk] = v;
  }
  __syncthreads();
  const int n = tid >> 2, kb = (tid & 3) * 16;
  u32x4 o0, o1;
#pragma unroll
  for (int j = 0; j < 4; ++j) {
    o0[j] = pack2(lds[n * 65 + kb + 2 * j], lds[n * 65 + kb + 2 * j + 1]);
    o1[j] = pack2(lds[n * 65 + kb + 8 + 2 * j], lds[n * 65 + kb + 8 + 2 * j + 1]);
  }
  u32x4* d = (u32x4*)(dst + (size_t)n * dst_ld + k0 + kb);
  d[0] = o0; d[1] = o1;
  __syncthreads();
}

DI void phase0(const Params& p, char* lds) {
  bfu* Win = (bfu*)(ows(p) + OFF_WIN);
  bfu* Wg = (bfu*)(ows(p) + OFF_WG);
  bfu* Wbr = (bfu*)(ows(p) + OFF_WBR);
  bfu* Wout = (bfu*)(ows(p) + OFF_WOUT);
  float* mod = (float*)(ows(p) + OFF_MOD);
  constexpr int T_IN = 118 * 16, T_BR = 384, T_OUT = 256, T_L = T_IN + T_BR + T_OUT;
  constexpr int N_MOD = 96;
  const int total = N_MOD + 2 * T_L;
  if (blockIdx.x == 0) {
    float* cs = (float*)(ows(p) + OFF_ROPE);
    for (int i = otid(); i < 1024; i += 256) {
      const int pos = i >> 4, f = i & 15;
      const float inv = powf(10000.f, -(float)f / 16.f);
      const float ang = (float)pos * inv;
      cs[i * 2] = cosf(ang); cs[i * 2 + 1] = sinf(ang);
    }
  }
  for (int u = blockIdx.x; u < total; u += gridDim.x) {
    if (u < N_MOD) {
      const int l = u / 48, j0 = (u % 48) * 64;
      float* sc = (float*)lds;
      float* red = sc + 9 * 1024;
      for (int i = otid(); i < 9 * 1024; i += 256) {
        int r = i >> 10, k = i & 1023;
        float v = (r < 8) ? p.c[r * 1024 + k] : p.c_ctx[k];
        sc[i] = v / (1.f + expf(-v));
      }
      __syncthreads();
      const int w = otid() >> 6, lane = otid() & 63;
      float acc[9];
#pragma unroll
      for (int r = 0; r < 9; ++r) acc[r] = 0.f;
      const float* wm = p.w_mod + (size_t)l * 1024 * 3072 + j0 + lane;
#pragma unroll 1
      for (int kb = w * 256; kb < w * 256 + 256; kb += 32) {
        float wv[32];
#pragma unroll
        for (int q = 0; q < 32; ++q) wv[q] = wm[(size_t)(kb + q) * 3072];
#pragma unroll
        for (int q = 0; q < 32; ++q)
#pragma unroll
          for (int r = 0; r < 9; ++r) acc[r] += sc[r * 1024 + kb + q] * wv[q];
      }
#pragma unroll
      for (int r = 0; r < 9; ++r) red[(w * 9 + r) * 64 + lane] = acc[r];
      __syncthreads();
      for (int i = otid(); i < 9 * 64; i += 256) {
        int r = i >> 6, ln = i & 63;
        float s = red[(0 * 9 + r) * 64 + ln] + red[(1 * 9 + r) * 64 + ln] + red[(2 * 9 + r) * 64 + ln] + red[(3 * 9 + r) * 64 + ln];
        mod[(size_t)(l * 9 + r) * 3072 + j0 + ln] = s + p.b_mod[l * 3072 + j0 + ln];
      }
      __syncthreads();
    } else {
      int v = u - N_MOD;
      const int l = v / T_L; v -= l * T_L;
      if (v < T_IN) {
        const int nt = v >> 4, kt = v & 15, n0 = nt * 64;
        const float* src = p.w_in + (size_t)l * 1024 * INC;
        if (n0 < 4480) {
          int col0, nvalid = 64;
          int col1 = -1;
          if (n0 < 2304) col0 = n0; else if (n0 < 4352) col0 = n0 + 16; else if (n0 == 4352) { col0 = 2304; nvalid = 16; } else { col0 = 0; nvalid = 0; }
          if (n0 >= PC_GLU && n0 < PC_GLU + 1024) { const int q = (n0 - PC_GLU) >> 6; col0 = 2832 + q * 32; col1 = 3344 + q * 32; }
          cvt_tile(src, INC, col0, nvalid, kt * 64, Win + ((size_t)l * 4480 + n0) * 1024, 1024, nullptr, (float*)lds, col1);
        } else {
          int j0 = n0 - 4480;
          cvt_tile(src, INC, 4368 + j0, 64, kt * 64, Wg + ((size_t)l * 3072 + j0) * 1024, 1024, nullptr, (float*)lds);
        }
      } else if (v < T_IN + T_BR) {
        int w = v - T_IN;
        const int br = w >> 7, nt = (w & 127) >> 3, kt = w & 7;
        const float *sb0 = p.w_br[0], *sb1 = p.w_br[1], *sb2 = p.w_br[2];
        asm volatile("" : "+s"(sb0), "+s"(sb1), "+s"(sb2));
        const float* src = (br == 0 ? sb0 : (br == 1 ? sb1 : sb2)) + (size_t)l * 512 * 1024;
        cvt_tile(src, 1024, nt * 64, 64, kt * 64, Wbr + ((size_t)(l * 3 + br) * 1024 + nt * 64) * 512, 512,
                 br == 1 ? p.ssd_norm_w + l * 512 : nullptr, (float*)lds);
      } else {
        int w = v - T_IN - T_BR;
        const int nt = w >> 4, kt = w & 15;
        cvt_tile(p.w_out + (size_t)l * 1024 * 1024, 1024, nt * 64, 64, kt * 64, Wout + ((size_t)l * 1024 + nt * 64) * 1024, 1024, nullptr, (float*)lds);
      }
    }
  }
}

DI void phaseA(const Params& p, int l) {
  const float* mod = (const float*)(ows(p) + OFF_MOD);
  bfu* H = (bfu*)(ows(p) + OFF_H);
  const float* xlat = (l == 0) ? p.x : p.out;
  const float* xctx = (l == 0) ? p.ctx : (const float*)(ows(p) + OFF_X1C);
  const int lane = otid() & 63;
  const int gw = blockIdx.x * 4 + (otid() >> 6), nw = gridDim.x * 4;
  const float* nwp = p.norm_w + l * 1024;
  for (int row = gw; row < NROWS; row += nw) {
    const float* src = (row < NLAT) ? xlat + (size_t)row * 1024 : xctx + (size_t)(row - NLAT) * 1024;
    const int mrow = (row < NLAT) ? (row >> 12) : 8;
    const float* md = mod + (size_t)(l * 9 + mrow) * 3072;
    f32x4 v[4];
    float ss = 0.f;
#pragma unroll
    for (int i = 0; i < 4; ++i) { v[i] = ((const f32x4*)src)[i * 64 + lane]; ss += v[i][0] * v[i][0] + v[i][1] * v[i][1] + v[i][2] * v[i][2] + v[i][3] * v[i][3]; }
    ss = wave_sum(ss);
    const float rstd = rsqrtf(ss * (1.f / 1024.f) + EPS);
#pragma unroll
    for (int i = 0; i < 4; ++i) {
      const int idx = (i * 64 + lane) * 4;
      f32x4 w4 = *(const f32x4*)(nwp + idx), sh = *(const f32x4*)(md + idx), sc = *(const f32x4*)(md + 1024 + idx);
      float o0 = v[i][0] * rstd * w4[0] * (1.f + sc[0]) + sh[0];
      float o1 = v[i][1] * rstd * w4[1] * (1.f + sc[1]) + sh[1];
      float o2 = v[i][2] * rstd * w4[2] * (1.f + sc[2]) + sh[2];
      float o3 = v[i][3] * rstd * w4[3] * (1.f + sc[3]) + sh[3];
      u32x2 o; o[0] = pack2(o0, o1); o[1] = pack2(o2, o3);
      *(u32x2*)(H + (size_t)row * 1024 + idx) = o;
    }
  }
}

#define GLDS16(gp, lp) __builtin_amdgcn_global_load_lds((const unsigned*)(gp), (unsigned*)(lp), 16, 0, 0)
#define WAIT_VM0() asm volatile("s_waitcnt vmcnt(0)" ::: "memory")
#define RAW_BARRIER() do { asm volatile("s_waitcnt lgkmcnt(0)" ::: "memory"); __builtin_amdgcn_s_barrier(); } while (0)
DI void gemm_prefetch(const bfu* __restrict__ W, int ldw, const bfu* __restrict__ A, int lda, char* lds) {
  const int tid = otid(), lane = tid & 63, w = tid >> 6;
  const int grow = lane >> 2;
  const int gch = ((lane & 3) ^ swz(grow)) * 8;
  const bfu* wsrc0 = W + (size_t)(w * 32 + grow) * ldw + gch;
  const bfu* wsrc1 = W + (size_t)(w * 32 + 16 + grow) * ldw + gch;
  const bfu* asrc0 = A + (size_t)(w * 32 + grow) * lda + gch;
  const bfu* asrc1 = A + (size_t)(w * 32 + 16 + grow) * lda + gch;
  char* sw = lds;
  char* sa = sw + 16384;
  GLDS16(wsrc0, sw + (w * 2) * 1024);
  GLDS16(wsrc1, sw + (w * 2 + 1) * 1024);
  GLDS16(wsrc0 + 32, sw + 8192 + (w * 2) * 1024);
  GLDS16(wsrc1 + 32, sw + 8192 + (w * 2 + 1) * 1024);
  GLDS16(asrc0, sa + (w * 2) * 1024);
  GLDS16(asrc1, sa + (w * 2 + 1) * 1024);
  GLDS16(asrc0 + 32, sa + 8192 + (w * 2) * 1024);
  GLDS16(asrc1 + 32, sa + 8192 + (w * 2 + 1) * 1024);
}
template <int NJ, bool LOWREG = false, bool PRE = false, bool PIPE = false>
DI void gemm_core(const bfu* __restrict__ W, int ldw, const bfu* __restrict__ A, int lda, int K,
                  f32x4 (&acc)[4][NJ], char* lds) {
  constexpr int ASLAB = NJ * 32 * 64;
  constexpr int STAGE = 16384 + 2 * ASLAB;
  const int tid = otid(), lane = tid & 63, w = tid >> 6;
  const int lr = lane & 15, g4 = lane >> 4;
  const int wn = w >> 1, wm = w & 1;
  const int grow = lane >> 2;
  const int gch = ((lane & 3) ^ swz(grow)) * 8;
  const bfu* wsrc0 = W + (size_t)(w * 32 + grow) * ldw + gch;
  const bfu* wsrc1 = W + (size_t)(w * 32 + 16 + grow) * ldw + gch;
  const bfu* asrc0 = A + (size_t)((NJ == 4 ? w * 32 : w * 16) + grow) * lda + gch;
  const bfu* asrc1 = A + (size_t)(w * 32 + 16 + grow) * lda + gch;
  auto issue = [&](int st, int k0) {
    char* sw = lds + st * STAGE;
    char* sa = sw + 16384;
    GLDS16(wsrc0 + k0, sw + (w * 2) * 1024);
    GLDS16(wsrc1 + k0, sw + (w * 2 + 1) * 1024);
    GLDS16(wsrc0 + k0 + 32, sw + 8192 + (w * 2) * 1024);
    GLDS16(wsrc1 + k0 + 32, sw + 8192 + (w * 2 + 1) * 1024);
    if (NJ == 4) {
      GLDS16(asrc0 + k0, sa + (w * 2) * 1024);
      GLDS16(asrc1 + k0, sa + (w * 2 + 1) * 1024);
      GLDS16(asrc0 + k0 + 32, sa + ASLAB + (w * 2) * 1024);
      GLDS16(asrc1 + k0 + 32, sa + ASLAB + (w * 2 + 1) * 1024);
    } else {
      GLDS16(asrc0 + k0, sa + w * 1024);
      GLDS16(asrc0 + k0 + 32, sa + ASLAB + w * 1024);
    }
  };
  const int fsw = (g4 ^ swz(lr)) * 16;
  const int nk = K >> 6;
  if (!PRE) issue(0, 0);
  WAIT_VM0();
  RAW_BARRIER();
  for (int kt = 0; kt < nk; ++kt) {
    const int cur = kt & 1;
    if (kt + 1 < nk) issue(cur ^ 1, (kt + 1) << 6);
    const char* sw = lds + cur * STAGE;
    const char* sa = sw + 16384;
    auto kstep = [&](int s) {
      bf16x8 af[4], bfr[NJ];
#pragma unroll
      for (int i = 0; i < 4; ++i) af[i] = *(const bf16x8*)(sw + s * 8192 + (wn * 64 + i * 16 + lr) * 64 + fsw);
#pragma unroll
      for (int j = 0; j < NJ; ++j) bfr[j] = *(const bf16x8*)(sa + s * ASLAB + (wm * (NJ * 16) + j * 16 + lr) * 64 + fsw);
#pragma unroll
      for (int i = 0; i < 4; ++i)
#pragma unroll
        for (int j = 0; j < NJ; ++j) acc[i][j] = mfma16(af[i], bfr[j], acc[i][j]);
    };
    if (LOWREG) {
#pragma unroll 1
      for (int s = 0; s < 2; ++s) kstep(s);
    } else if (NJ == 4 && PIPE) {
      bf16x8 a0[4], b0[4], a1[4], b1[4];
#pragma unroll
      for (int i = 0; i < 4; ++i) a0[i] = *(const bf16x8*)(sw + (wn * 64 + i * 16 + lr) * 64 + fsw);
#pragma unroll
      for (int j = 0; j < 4; ++j) b0[j] = *(const bf16x8*)(sa + (wm * 64 + j * 16 + lr) * 64 + fsw);
#pragma unroll
      for (int i = 0; i < 4; ++i) a1[i] = *(const bf16x8*)(sw + 8192 + (wn * 64 + i * 16 + lr) * 64 + fsw);
#pragma unroll
      for (int j = 0; j < 4; ++j) b1[j] = *(const bf16x8*)(sa + ASLAB + (wm * 64 + j * 16 + lr) * 64 + fsw);
      __builtin_amdgcn_sched_barrier(0);
#pragma unroll
      for (int i = 0; i < 4; ++i)
#pragma unroll
        for (int j = 0; j < 4; ++j) acc[i][j] = mfma16(a0[i], b0[j], acc[i][j]);
#pragma unroll
      for (int i = 0; i < 4; ++i)
#pragma unroll
        for (int j = 0; j < 4; ++j) acc[i][j] = mfma16(a1[i], b1[j], acc[i][j]);
    } else {
      kstep(0); kstep(1);
    }
    if (PIPE) __builtin_amdgcn_sched_barrier(0);
    WAIT_VM0();
    RAW_BARRIER();
  }
}


DI char* epi_block_base(char* lds, int w) { return lds + 32768 + (2 * w) * 1024; }
DI void epi_put(char* eb, int i, int j, int lr, int g4, unsigned v0, unsigned v1) {
  const int row = j * 16 + lr;
  const int c = i * 2 + (g4 >> 1);
  char* a = eb + (row >> 4) * 8192 + ((row >> 3) & 1) * 1024 + (row & 7) * 128 + ((c ^ (row & 7)) * 16) + (g4 & 1) * 8;
  u32x2 v; v[0] = v0; v[1] = v1;
  *(u32x2*)a = v;
}
DI void epi_flush(const char* eb, int lane, bfu* dst  , size_t ld) {
#pragma unroll
  for (int ps = 0; ps < 8; ++ps) {
    const int row = ps * 8 + (lane >> 3), c = lane & 7;
    const u32x4 v = *(const u32x4*)(eb + (row >> 4) * 8192 + ((row >> 3) & 1) * 1024 + (row & 7) * 128 + ((c ^ (row & 7)) * 16));
    *(u32x4*)(dst + (size_t)row * ld + c * 8) = v;
  }
}

DI void g256_issue(const bfu* __restrict__ W, int ldw, const bfu* __restrict__ A, int lda, int k0, char* buf) {
  const int tid = otid(), lane = tid & 63, w = tid >> 6;
  const int grow = lane >> 2;
  const int gch = ((lane & 3) ^ swz(grow)) * 8;
  const bfu* wsrc = W + (size_t)(w * 32 + grow) * ldw + k0 + gch;
  const bfu* asrc = A + (size_t)(w * 64 + grow) * lda + k0 + gch;
  char* sw = buf + (w * 2) * 1024;
  char* sa = buf + 16384 + (w * 4) * 1024;
#pragma unroll
  for (int sl = 0; sl < 2; ++sl) {
    GLDS16(wsrc + sl * 32, sw + sl * 8192);
    GLDS16(wsrc + sl * 32 + (size_t)16 * ldw, sw + sl * 8192 + 1024);
    GLDS16(asrc + sl * 32, sa + sl * 16384);
    GLDS16(asrc + sl * 32 + (size_t)16 * lda, sa + sl * 16384 + 1024);
    GLDS16(asrc + sl * 32 + (size_t)32 * lda, sa + sl * 16384 + 2048);
    GLDS16(asrc + sl * 32 + (size_t)48 * lda, sa + sl * 16384 + 3072);
  }
}
DI void g256_prefetch(const bfu* __restrict__ W, int ldw, const bfu* __restrict__ A, int lda, char* lds) { g256_issue(W, ldw, A, lda, 0, lds); }
DI void g256_core(const bfu* __restrict__ W, int ldw, const bfu* __restrict__ A, int lda, int K, f32x4 (&acc)[4][8], char* lds) {
  const int tid = otid(), lane = tid & 63, w = tid >> 6;
  const int lr = lane & 15, g4 = lane >> 4;
  const int wn = w >> 1, wm = w & 1;
  const int fsw = (g4 ^ swz(lr)) * 16;
  const int nk = K >> 6;
  const char* sw = lds + (wn * 64 + lr) * 64 + fsw;
  const char* sa = lds + 16384 + (wm * 128 + lr) * 64 + fsw;
  for (int kt = 0; kt < nk; ++kt) {
    WAIT_VM0();
    RAW_BARRIER();
#pragma unroll
    for (int sl = 0; sl < 2; ++sl) {
      bf16x8 af[4];
#pragma unroll
      for (int i = 0; i < 4; ++i) af[i] = *(const bf16x8*)(sw + sl * 8192 + i * 1024);
#pragma unroll
      for (int jh = 0; jh < 2; ++jh) {
        bf16x8 bfr[4];
#pragma unroll
        for (int j = 0; j < 4; ++j) bfr[j] = *(const bf16x8*)(sa + sl * 16384 + (jh * 4 + j) * 1024);
#pragma unroll
        for (int i = 0; i < 4; ++i)
#pragma unroll
          for (int j = 0; j < 4; ++j) acc[i][jh * 4 + j] = mfma16(af[i], bfr[j], acc[i][jh * 4 + j]);
      }
    }
    RAW_BARRIER();
    if (kt + 1 < nk) g256_issue(W, ldw, A, lda, (kt + 1) << 6, lds);
  }
}
DI void epi2_put(char* buf, int i, int jj, int lr, int g4, unsigned v0, unsigned v1) {
  const int row = jj * 16 + lr, c = i * 2 + (g4 >> 1);
  u32x2 v; v[0] = v0; v[1] = v1;
  *(u32x2*)(buf + row * 128 + ((c ^ (row & 7)) * 16) + (g4 & 1) * 8) = v;
}
DI void epi2_flush(const char* buf, int lane, bfu* dst, size_t ld) {
#pragma unroll
  for (int ps = 0; ps < 4; ++ps) {
    const int row = ps * 8 + (lane >> 3), c = lane & 7;
    const u32x4 v = *(const u32x4*)(buf + row * 128 + ((c ^ (row & 7)) * 16));
    *(u32x4*)(dst + (size_t)row * ld + c * 8) = v;
  }
}

DI void phaseB(const Params& p, int l, char* lds) {
  const bfu* Win = (const bfu*)(ows(p) + OFF_WIN) + (size_t)l * 4480 * 1024;
  const bfu* H = (const bfu*)(ows(p) + OFF_H);
  bfu* P = (bfu*)(ows(p) + OFF_P);
  float* dtraw = (float*)(ows(p) + OFF_DT);
  const int lane = otid() & 63, w = otid() >> 6, lr = lane & 15, g4 = lane >> 4, wn = w >> 1, wm = w & 1;
  constexpr int NT = 35;
  const int MT = (l == 0) ? NROWS / 256 : NLAT / 256, MX = MT / 8;
  const int nmain = NT * MT;
  const int total = (l == 0) ? nmain : nmain + 8 * 11;
  auto decode = [&](int u, int& tn, int& tm) {
    if (u >= nmain) {
      const int c = u - nmain, q = c % 11;
      tm = NLAT / 256 + c / 11;
      tn = (q < 2) ? 4 + q : (q < 10 ? 8 + q : 34);
      return;
    }
    const int xcd = u & 7, j = u >> 3;
    int tml;
    if (j < 4 * 8 * MX) { const int strip = j / (8 * MX), r = j % (8 * MX); tml = r >> 3; tn = strip * 8 + (r & 7); }
    else { const int r = j - 4 * 8 * MX; tml = r / 3; tn = 32 + r % 3; }
    tm = xcd * MX + tml;
  };
  if ((int)blockIdx.x < total) { int tn, tm; decode(blockIdx.x, tn, tm); g256_prefetch(Win + (size_t)tn * 128 * 1024, 1024, H + (size_t)tm * 256 * 1024, 1024, lds); }
  for (int u = blockIdx.x; u < total; u += gridDim.x) {
    int tn, tm; decode(u, tn, tm);
    const int n0 = tn * 128, m0 = tm * 256;
    f32x4 acc[4][8];
#pragma unroll
    for (int i = 0; i < 4; ++i)
#pragma unroll
      for (int j = 0; j < 8; ++j) acc[i][j] = f32x4{0.f, 0.f, 0.f, 0.f};
    g256_core(Win + (size_t)n0 * 1024, 1024, H + (size_t)m0 * 1024, 1024, 1024, acc, lds);
    if (u + (int)gridDim.x < total) { int tn2, tm2; decode(u + gridDim.x, tn2, tm2); g256_prefetch(Win + (size_t)tn2 * 128 * 1024, 1024, H + (size_t)tm2 * 256 * 1024, 1024, lds); }
    const bool isctx = m0 >= NLAT;
    const int bb = isctx ? ((m0 - NLAT) >> 8) : (m0 >> 12);
    const int key_base = (isctx ? 4096 : (m0 & 4095)) + wm * 128;
    if (tn < 5) {
      const bool isk = (tn == 4);
      const float* nwp = (isk ? p.k_norm_w : p.q_norm_w) + l * 64 + 4 * g4;
      f32x4 nwv[4];
#pragma unroll
      for (int i = 0; i < 4; ++i) nwv[i] = *(const f32x4*)(nwp + i * 16);
      const float* cs = (const float*)(ows(p) + OFF_ROPE);
      const float osc = isk ? 1.f : QSCALE;
      char* buf = lds + 49152 + w * 4096;
      bfu* Kp = (bfu*)(ows(p) + OFF_KP);
#pragma unroll
      for (int ps = 0; ps < 4; ++ps) {
#pragma unroll
        for (int jj = 0; jj < 2; ++jj) {
          const int j = ps * 2 + jj;
          f32x4 v[4];
          float ss = 0.f;
#pragma unroll
          for (int i = 0; i < 4; ++i) { v[i] = acc[i][j]; ss += v[i][0] * v[i][0] + v[i][1] * v[i][1] + v[i][2] * v[i][2] + v[i][3] * v[i][3]; }
          ss += __shfl_xor(ss, 16);
          ss += __shfl_xor(ss, 32);
          const float rstd = rsqrtf(ss * (1.f / 64.f) + EPS);
#pragma unroll
          for (int i = 0; i < 4; ++i)
#pragma unroll
            for (int r = 0; r < 4; ++r) v[i][r] = v[i][r] * rstd * nwv[i][r];
          if (!isctx) {
            const int t = (m0 & 4095) + wm * 128 + j * 16 + lr;
            const float* cr = cs + ((t >> 6) * 16 + 4 * g4) * 2;
            const float* cc = cs + ((t & 63) * 16 + 4 * g4) * 2;
            const f32x4 r0 = *(const f32x4*)cr, r1 = *(const f32x4*)(cr + 4), c0 = *(const f32x4*)cc, c1 = *(const f32x4*)(cc + 4);
            const float rcs[8] = {r0[0], r0[1], r0[2], r0[3], r1[0], r1[1], r1[2], r1[3]};
            const float ccs[8] = {c0[0], c0[1], c0[2], c0[3], c1[0], c1[1], c1[2], c1[3]};
#pragma unroll
            for (int r = 0; r < 4; ++r) {
              float co = rcs[2 * r], si = rcs[2 * r + 1];
              float x1 = v[0][r], x2 = v[1][r];
              v[0][r] = x1 * co - x2 * si; v[1][r] = x2 * co + x1 * si;
              co = ccs[2 * r]; si = ccs[2 * r + 1];
              x1 = v[2][r]; x2 = v[3][r];
              v[2][r] = x1 * co - x2 * si; v[3][r] = x2 * co + x1 * si;
            }
          }
#pragma unroll
          for (int i = 0; i < 4; ++i)
            epi2_put(buf, i, jj, lr, g4, pack2(v[i][0] * osc, v[i][1] * osc), pack2(v[i][2] * osc, v[i][3] * osc));
        }
        if (isk) epi2_flush(buf, lane, Kp + ((size_t)(bb * 2 + wn) * NKEY + key_base + ps * 32) * 64, 64);
        else epi2_flush(buf, lane, P + (size_t)(m0 + wm * 128 + ps * 32) * PS + n0 + wn * 64, PS);
      }
    } else if (tn == 5) {
      char* buf = lds + 49152 + w * 4096;
      bfu* Vt = (bfu*)(ows(p) + OFF_VT);
#pragma unroll
      for (int ps = 0; ps < 4; ++ps) {
#pragma unroll
        for (int i = 0; i < 4; ++i)
#pragma unroll
          for (int jj = 0; jj < 2; ++jj)
#pragma unroll
            for (int r = 0; r < 4; ++r)
              *(bfu*)(buf + (i * 16 + 4 * g4 + r) * 64 + (jj * 16 + lr) * 2) = f2bf(acc[i][ps * 2 + jj][r]);
#pragma unroll
        for (int q = 0; q < 4; ++q) {
          const int chunk = q * 64 + lane, d = chunk >> 2, c = chunk & 3;
          const u32x4 vv = *(const u32x4*)(buf + d * 64 + c * 16);
          *(u32x4*)(Vt + ((size_t)(bb * 2 + wn) * 64 + d) * NKEY + key_base + ps * 32 + c * 8) = vv;
        }
      }
    } else if (tn >= 22 && tn < 30) {
      const int ch0 = ((tn - 22) * 2 + wn) * 32 + 4 * g4;
#pragma unroll
      for (int j = 0; j < 8; ++j) {
        const size_t ro = (size_t)(m0 + wm * 128 + j * 16 + lr) * PS + PC_GLU + ch0;
#pragma unroll
        for (int i = 0; i < 2; ++i) {
          u32x2 o;
          o[0] = pack2(acc[i][j][0] * sigmoidf_(acc[i + 2][j][0]), acc[i][j][1] * sigmoidf_(acc[i + 2][j][1]));
          o[1] = pack2(acc[i][j][2] * sigmoidf_(acc[i + 2][j][2]), acc[i][j][3] * sigmoidf_(acc[i + 2][j][3]));
          *(u32x2*)(P + ro + i * 16) = o;
        }
      }
    } else if (tn < 34) {
      const bool act = (tn >= 6 && tn < 10) || (tn >= 18 && tn < 22) || tn >= 30;
      char* buf = lds + 49152 + w * 4096;
#pragma unroll
      for (int ps = 0; ps < 4; ++ps) {
#pragma unroll
        for (int i = 0; i < 4; ++i)
#pragma unroll
          for (int jj = 0; jj < 2; ++jj)
          {
            f32x4 a = acc[i][ps * 2 + jj];
            if (act) { a[0] = siluf_(a[0]); a[1] = siluf_(a[1]); a[2] = siluf_(a[2]); a[3] = siluf_(a[3]); }
            epi2_put(buf, i, jj, lr, g4, pack2(a[0], a[1]), pack2(a[2], a[3]));
          }
        epi2_flush(buf, lane, P + (size_t)(m0 + wm * 128 + ps * 32) * PS + n0 + wn * 64, PS);
      }
    } else if (wn == 0) {
      const f32x4 dbias = *(const f32x4*)(p.ssd_dt_bias + l * 16 + 4 * g4);
#pragma unroll
      for (int j = 0; j < 8; ++j) {
        const int m = m0 + wm * 128 + j * 16 + lr;
        f32x4 o;
#pragma unroll
        for (int r = 0; r < 4; ++r) {
          const float x = acc[0][j][r] + dbias[r], ex = fexp(x);
          const float sp = (ex < 0.01f) ? ex * (1.f - ex * (0.5f - ex * (1.f / 3.f))) : __builtin_amdgcn_logf(1.f + ex) * 0.6931471805599453f;
          o[r] = (x > 20.f) ? x : sp;
        }
        *(f32x4*)(dtraw + (size_t)m * 16 + 4 * g4) = o;
      }
    }
  }
}

DI void prep_unit(const Params& p, int l, int tile, const float* cs  , const float* qkw  , bool dry = false) {
  bfu* P = (bfu*)(ows(p) + OFF_P);
  bfu* Kp = (bfu*)(ows(p) + OFF_KP);
  bfu* Vt = (bfu*)(ows(p) + OFF_VT);
  float* dt = (float*)(ows(p) + OFF_DT);
  const int tid = otid();
  const int R0 = tile * 64;
  const bool isctx = R0 >= NLAT;
  const int b = isctx ? ((R0 - NLAT) >> 8) : (R0 >> 12);
  const int t0 = isctx ? ((R0 - NLAT) & 255) : (R0 & 4095);
  const int key0 = isctx ? 4096 + t0 : t0;
  for (int it = tid; it < 640; it += 256) {
    const int rr = it / 10, hh = it - rr * 10;
    const int row = R0 + rr;
    bfu* src = P + (size_t)row * PS + (hh < 8 ? hh * 64 : PC_K + (hh - 8) * 64);
    float v[64];
    float ss = 0.f;
#pragma unroll
    for (int i = 0; i < 8; ++i) {
      u32x4 raw = ((const u32x4*)src)[i];
#pragma unroll
      for (int e = 0; e < 4; ++e) { v[i * 8 + 2 * e] = lo_f(raw[e]); v[i * 8 + 2 * e + 1] = hi_f(raw[e]); }
    }
#pragma unroll
    for (int d = 0; d < 64; ++d) ss += v[d] * v[d];
    const float rstd = rsqrtf(ss * (1.f / 64.f) + EPS);
    const float* nw = qkw + (hh < 8 ? 0 : 64);
#pragma unroll
    for (int d = 0; d < 64; ++d) v[d] = v[d] * rstd * nw[d];
    if (!isctx) {
      const int t = t0 + rr;
      const int rp = t >> 6, cp = t & 63;
#pragma unroll
      for (int f = 0; f < 16; ++f) {
        float c = cs[(rp * 16 + f) * 2], s = cs[(rp * 16 + f) * 2 + 1];
        float x1 = v[f], x2 = v[16 + f];
        v[f] = x1 * c - x2 * s; v[16 + f] = x2 * c + x1 * s;
        c = cs[(cp * 16 + f) * 2]; s = cs[(cp * 16 + f) * 2 + 1];
        x1 = v[32 + f]; x2 = v[48 + f];
        v[32 + f] = x1 * c - x2 * s; v[48 + f] = x2 * c + x1 * s;
      }
    }
    bfu* dst;
    float sc = 1.f;
    if (hh < 8) { dst = src; sc = QSCALE; }
    else dst = Kp + ((size_t)(b * 2 + (hh - 8)) * NKEY + key0 + rr) * 64;
#pragma unroll
    for (int i = 0; i < 8; ++i) {
      u32x4 o;
#pragma unroll
      for (int e = 0; e < 4; ++e) o[e] = pack2(v[i * 8 + 2 * e] * sc, v[i * 8 + 2 * e + 1] * sc);
      if (!dry) ((u32x4*)dst)[i] = o;
    }
  }
  {
    const int c = tid & 127, half = tid >> 7, kv = c >> 6, d = c & 63;
    u32x4 o[4];
#pragma unroll
    for (int j = 0; j < 16; ++j) {
      const int row = R0 + half * 32 + 2 * j;
      unsigned a = P[(size_t)row * PS + PC_V + c], b2 = P[(size_t)(row + 1) * PS + PC_V + c];
      o[j >> 2][j & 3] = a | (b2 << 16);
    }
    u32x4* dst = (u32x4*)(Vt + ((size_t)(b * 2 + kv) * 64 + d) * NKEY + key0 + half * 32);
#pragma unroll
    for (int j = 0; j < 4; ++j) if (!dry) dst[j] = o[j];
  }
  {
    const int idx = tid * 4, row = R0 + (idx >> 4), j = idx & 15;
    f32x4 r = *(f32x4*)(dt + (size_t)row * 16 + j);
    const float* bias = p.ssd_dt_bias + l * 16 + j;
#pragma unroll
    for (int e = 0; e < 4; ++e) { float x = r[e] + bias[e]; r[e] = (x > 20.f) ? x : log1pf(expf(x)); }
    if (!dry) *(f32x4*)(dt + (size_t)row * 16 + j) = r;
  }
}

DI void conf_unit(const Params& p, int l, int tile32, char* lds, bool dry = false) {
  bfu* P = (bfu*)(ows(p) + OFF_P);
  const int tid = otid(), lane = tid & 63, w = tid >> 6;
  const int R0 = tile32 * 32;
  const bool isctx = R0 >= NLAT;
  const int S0 = isctx ? NLAT + (((R0 - NLAT) >> 8) << 8) : ((R0 >> 12) << 12);
  const int Ls = isctx ? 256 : 4096;
  const int t0 = R0 - S0;
  bfu* vt = (bfu*)lds;
  float* red = (float*)(lds + 63488);
  for (int it = tid; it < 62 * 64; it += 256) {
    const int rr = it >> 6, ck = it & 63;
    const int t = t0 - 15 + rr;
    u32x4 o = u32x4{0u, 0u, 0u, 0u};
    if (t >= 0 && t < Ls) {
      const bfu* rp = P + (size_t)(S0 + t) * PS + PC_GLU + ck * 8;
      o = *(const u32x4*)rp;
    }
    *(u32x4*)(vt + rr * 512 + ck * 8) = o;
  }
  __syncthreads();
  const int c0 = 2 * tid;
  float w0[31], w1[31];
#pragma unroll
  for (int k = 0; k < 31; ++k) {
    const float* wp = p.cm_conv_w + ((size_t)l * 31 + k) * 512 + c0;
    w0[k] = wp[0]; w1[k] = wp[1];
  }
  const float bias0 = p.cm_conv_b[l * 512 + c0], bias1 = p.cm_conv_b[l * 512 + c0 + 1];
  const float lw0 = p.cm_ln_w[l * 512 + c0], lw1 = p.cm_ln_w[l * 512 + c0 + 1];
  const float lb0 = p.cm_ln_b[l * 512 + c0], lb1 = p.cm_ln_b[l * 512 + c0 + 1];
#pragma unroll 1
  for (int half = 0; half < 2; ++half) {
    float o0[16], o1[16];
#pragma unroll
    for (int o = 0; o < 16; ++o) { o0[o] = bias0; o1[o] = bias1; }
    const bfu* vb = vt + (half * 16) * 512 + c0;
#pragma unroll
    for (int r = 0; r < 46; ++r) {
      const unsigned pr = *(const unsigned*)(vb + r * 512);
      const float a = lo_f(pr), b2 = hi_f(pr);
#pragma unroll
      for (int o = 0; o < 16; ++o) {
        const int k = r - o;
        if (k >= 0 && k <= 30) { o0[o] += w0[k] * a; o1[o] += w1[k] * b2; }
      }
    }
#pragma unroll
    for (int o = 0; o < 16; ++o) {
      float s1 = wave_sum(o0[o] + o1[o]);
      float s2 = wave_sum(o0[o] * o0[o] + o1[o] * o1[o]);
      if (lane == 0) { red[(w * 16 + o) * 2] = s1; red[(w * 16 + o) * 2 + 1] = s2; }
    }
    __syncthreads();
#pragma unroll
    for (int o = 0; o < 16; ++o) {
      float s1 = red[o * 2] + red[(16 + o) * 2] + red[(32 + o) * 2] + red[(48 + o) * 2];
      float s2 = red[o * 2 + 1] + red[(16 + o) * 2 + 1] + red[(32 + o) * 2 + 1] + red[(48 + o) * 2 + 1];
      const float mu = s1 * (1.f / 512.f);
      const float var = fmaxf(s2 * (1.f / 512.f) - mu * mu, 0.f);
      const float rstd = rsqrtf(var + EPS);
      unsigned* gp = (unsigned*)(P + (size_t)(R0 + half * 16 + o) * PS + PC_GCV + c0);
      const unsigned gv = *gp;
      float y0 = siluf_((o0[o] - mu) * rstd * lw0 + lb0) * lo_f(gv);
      float y1 = siluf_((o1[o] - mu) * rstd * lw1 + lb1) * hi_f(gv);
      if (!dry) *gp = pack2(y0, y1);
    }
    __syncthreads();
  }
}

DI void phaseC1(const Params& p, int l, char* lds, bool dry = false) {
  const int nconf = (l == 0) ? NROWS / 32 : NLAT / 32;
  for (int u = blockIdx.x; u < nconf; u += gridDim.x) conf_unit(p, l, (u & 7) * (nconf >> 3) + (u >> 3), lds, dry);
}

DI void attn_unit(const Params& p, int l, int u, char* lds, bool dry = false) {
  bfu* P = (bfu*)(ows(p) + OFF_P);
  const bfu* Kp = (const bfu*)(ows(p) + OFF_KP);
  const bfu* Vt = (const bfu*)(ows(p) + OFF_VT);
  const int tid = otid(), lane = tid & 63, w = tid >> 6, lr = lane & 15, g4 = lane >> 4;
  int b, kv, Rq0, key_lo;
  if (u < 1024) { const int pair = (u & 7) * 2 + (u >> 9); b = pair >> 1; kv = pair & 1; Rq0 = b * 4096 + ((u >> 3) & 63) * 64; key_lo = 0; }
  else { const int v = u - 1024; b = v >> 3; kv = (v >> 2) & 1; Rq0 = NLAT + b * 256 + (v & 3) * 64; key_lo = 4096; }
  const int nt = (NKEY - key_lo) >> 6;
  const int head = kv * 4 + w;
  bf16x8 qf[4][2];
#pragma unroll
  for (int qt = 0; qt < 4; ++qt)
#pragma unroll
    for (int s = 0; s < 2; ++s)
      qf[qt][s] = *(const bf16x8*)(P + (size_t)(Rq0 + qt * 16 + lr) * PS + head * 64 + s * 32 + g4 * 8);
  const bfu* Kb = Kp + (size_t)(b * 2 + kv) * NKEY * 64;
  const bfu* Vb = Vt + (size_t)(b * 2 + kv) * 64 * NKEY;
  constexpr int STAGE = 8192 + 10240;
  const int lrow = tid >> 2, lc = tid & 3;
  const int lcs = (lc ^ swz(lrow)) * 16;
  u32x4 kr[2], vr[2];
  auto gload = [&](int key0) {
    kr[0] = *(const u32x4*)(Kb + (size_t)(key0 + lrow) * 64 + lc * 8);
    kr[1] = *(const u32x4*)(Kb + (size_t)(key0 + lrow) * 64 + 32 + lc * 8);
    vr[0] = *(const u32x4*)(Vb + (size_t)lrow * NKEY + key0 + lc * 8);
    vr[1] = *(const u32x4*)(Vb + (size_t)lrow * NKEY + key0 + 32 + lc * 8);
  };
  auto lstore = [&](int st) {
    char* sk = lds + st * STAGE;
    char* sv = sk + 8192;
    *(u32x4*)(sk + lrow * 64 + lcs) = kr[0];
    *(u32x4*)(sk + 4096 + lrow * 64 + lcs) = kr[1];
    *(u32x4*)(sv + lrow * 80 + lc * 16) = vr[0];
    *(u32x4*)(sv + 5120 + lrow * 80 + lc * 16) = vr[1];
  };
  float nshift;
  {
    float wq = fabsf(p.q_norm_w[l * 64 + lane]), wk = fabsf(p.k_norm_w[l * 64 + lane]);
#pragma unroll
    for (int o = 32; o >= 1; o >>= 1) { wq = fmaxf(wq, __shfl_xor(wq, o)); wk = fmaxf(wk, __shfl_xor(wk, o)); }
    nshift = -(64.f * QSCALE) * wq * wk;
  }
  f32x4 O[4][4];
  float lrun[4];
#pragma unroll
  for (int qt = 0; qt < 4; ++qt) {
    lrun[qt] = 0.f;
#pragma unroll
    for (int d = 0; d < 4; ++d) O[qt][d] = f32x4{0.f, 0.f, 0.f, 0.f};
  }
  const int fsw = (g4 ^ swz(lr)) * 16;
  gload(key_lo);
  lstore(0);
  __syncthreads();
#pragma unroll 2
  for (int t = 0; t < nt; ++t) {
    const int cur = t & 1;
    if (t + 1 < nt) gload(key_lo + (t + 1) * 64);
    const char* sk = lds + cur * STAGE;
    const char* sv = sk + 8192;
#pragma unroll
    for (int kb = 0; kb < 2; ++kb) {
      bf16x8 kf[2][2], vf[4];
#pragma unroll
      for (int t2 = 0; t2 < 2; ++t2)
#pragma unroll
        for (int s = 0; s < 2; ++s)
          kf[t2][s] = *(const bf16x8*)(sk + s * 4096 + (kb * 32 + t2 * 16 + lr) * 64 + fsw);
#pragma unroll
      for (int d = 0; d < 4; ++d) {
        const char* vp = sv + kb * 5120 + (d * 16 + lr) * 80 + g4 * 8;
        u32x2 lo = *(const u32x2*)vp, hi = *(const u32x2*)(vp + 32);
        u32x4 vv; vv[0] = lo[0]; vv[1] = lo[1]; vv[2] = hi[0]; vv[3] = hi[1];
        vf[d] = as_bf8(vv);
      }
#pragma unroll
      for (int qt = 0; qt < 4; ++qt) {
        f32x4 s0 = f32x4{nshift, nshift, nshift, nshift}, s1 = s0;
        s0 = mfma16(kf[0][0], qf[qt][0], s0); s0 = mfma16(kf[0][1], qf[qt][1], s0);
        s1 = mfma16(kf[1][0], qf[qt][0], s1); s1 = mfma16(kf[1][1], qf[qt][1], s1);
        const float p0 = fexp2(s0[0]), p1 = fexp2(s0[1]), p2 = fexp2(s0[2]), p3 = fexp2(s0[3]);
        const float p4 = fexp2(s1[0]), p5 = fexp2(s1[1]), p6 = fexp2(s1[2]), p7 = fexp2(s1[3]);
        lrun[qt] += ((p0 + p1) + (p2 + p3)) + ((p4 + p5) + (p6 + p7));
        u32x4 pp; pp[0] = pack2(p0, p1); pp[1] = pack2(p2, p3); pp[2] = pack2(p4, p5); pp[3] = pack2(p6, p7);
        const bf16x8 pb = as_bf8(pp);
#pragma unroll
        for (int d = 0; d < 4; ++d) {
          O[qt][d] = mfma16(vf[d], pb, O[qt][d]);
        }
      }
    }
    if (t + 1 < nt) lstore(cur ^ 1);
    __syncthreads();
  }
#pragma unroll
  for (int qt = 0; qt < 4; ++qt) {
    float lsum = lrun[qt];
    lsum += __shfl_xor(lsum, 16);
    lsum += __shfl_xor(lsum, 32);
    const float inv = 1.f / lsum;
    const size_t rowoff = (size_t)(Rq0 + qt * 16 + lr) * PS;
#pragma unroll
    for (int d = 0; d < 4; ++d) {
      const int col = head * 64 + d * 16 + 4 * g4;
      const u32x2 gr = *(const u32x2*)(P + rowoff + PC_GA + col);
      u32x2 o;
      o[0] = pack2(O[qt][d][0] * inv * lo_f(gr[0]), O[qt][d][1] * inv * hi_f(gr[0]));
      o[1] = pack2(O[qt][d][2] * inv * lo_f(gr[1]), O[qt][d][3] * inv * hi_f(gr[1]));
      if (!dry) *(u32x2*)(P + rowoff + PC_Q + col) = o;
    }
  }
}

DI void ssdconv_unit(const Params& p, int l, int u, char* lds) {
  bfu* P = (bfu*)(ows(p) + OFF_P);
  bfu* BT = (bfu*)(ows(p) + OFF_BT);
  const int tid = otid();
  const int tile = u >> 2, cb = u & 3;
  const int R0 = tile * 64;
  const bool isctx = R0 >= NLAT;
  const int S0 = isctx ? NLAT + (((R0 - NLAT) >> 8) << 8) : ((R0 >> 12) << 12);
  const int Ls = isctx ? 256 : 4096;
  const int t0 = R0 - S0;
  bfu* xt = (bfu*)lds;
  for (int it = tid; it < 68 * 32; it += 256) {
    const int rr = it >> 5, ck = it & 31;
    const int t = t0 - 2 + rr;
    u32x4 v = u32x4{0u, 0u, 0u, 0u};
    if (t >= 0 && t < Ls) v = *(const u32x4*)(P + (size_t)(S0 + t) * PS + PC_XBC + cb * 256 + ck * 8);
    *(u32x4*)(xt + rr * 256 + ck * 8) = v;
  }
  __syncthreads();
  const int ch = cb * 256 + tid;
  float wk[5];
#pragma unroll
  for (int k = 0; k < 5; ++k) wk[k] = p.ssd_conv_w[((size_t)l * 5 + k) * 1024 + ch];
  const float bias = p.ssd_conv_b[l * 1024 + ch];
  const int Rc = R0 & ~127;
  for (int grp = 0; grp < 8; ++grp) {
    float o[8];
#pragma unroll
    for (int e = 0; e < 8; ++e) {
      const int tt = grp * 8 + e;
      float a = bias;
#pragma unroll
      for (int k = 0; k < 5; ++k) a += wk[k] * bf2f(xt[(tt + k) * 256 + tid]);
      o[e] = siluf_(a);
    }
    u32x4 pk; pk[0] = pack2(o[0], o[1]); pk[1] = pack2(o[2], o[3]); pk[2] = pack2(o[4], o[5]); pk[3] = pack2(o[6], o[7]);
    if (cb < 2) {
      const int tok = (R0 & 127) + grp * 8;
      *(u32x4*)(P + (size_t)(Rc + (ch >> 2)) * PS + PC_GLU + (ch & 3) * 128 + tok) = pk;
    } else {
#pragma unroll
      for (int e = 0; e < 8; ++e) P[(size_t)(R0 + grp * 8 + e) * PS + PC_GLU + ch] = f2bf(o[e]);
      if (cb == 2) *(u32x4*)(BT + (size_t)(ch - 512) * NROWS + R0 + grp * 8) = pk;
    }
  }
  __syncthreads();
}

DI void phaseC2(const Params& p, int l, char* lds, bool dry = false) {
  const int nattn = (l == 0) ? 1088 : 1024;
  const int nconv = (NROWS / 64) * 4;
  for (int u = blockIdx.x; u < nattn + nconv; u += gridDim.x) {
    if (u < nattn) attn_unit(p, l, u, lds, dry);
    else if (!dry) ssdconv_unit(p, l, u - nattn, lds);
  }
}

DI void chunk_info(int ci, int& b, int& slot) {
  if (ci < 256) { b = ci >> 5; slot = 2 + (ci & 31); } else { b = (ci - 256) >> 1; slot = (ci - 256) & 1; }
}
DI size_t xT_off(int R0, int ch, int tok) { return (size_t)(R0 + (ch >> 2)) * PS + PC_GLU + (ch & 3) * 128 + tok; }

DI void chunk_cumsum(const float* dt, int R0, int col, float A, int lane, float& d0, float& d1, float& inc0, float& inc1,
                     float& exc0, float& exc1, float& total) {
  d0 = dt[(size_t)(R0 + 2 * lane) * 16 + col];
  d1 = dt[(size_t)(R0 + 2 * lane + 1) * 16 + col];
  const float a0 = d0 * A, a1 = d1 * A;
  const float local = a0 + a1;
  float inc = local;
#pragma unroll
  for (int o = 1; o < 64; o <<= 1) { float t = __shfl_up(inc, o); if (lane >= o) inc += t; }
  const float excl = inc - local;
  exc0 = excl; exc1 = excl + a0; inc0 = excl + a0; inc1 = inc;
  total = __shfl(inc, 63);
}

DI void sloc_unit(const Params& p, int l, int u, char* lds) {
  const bfu* P = (const bfu*)(ows(p) + OFF_P);
  const bfu* BT = (const bfu*)(ows(p) + OFF_BT);
  const float* dt = (const float*)(ows(p) + OFF_DT);
  bfu* St = (bfu*)(ows(p) + OFF_ST);
  float* dec = (float*)(ows(p) + OFF_DEC);
  const int tid = otid(), lane = tid & 63, w = tid >> 6, lr = lane & 15, g4 = lane >> 4;
  const int h = (u >> 3) & 7, ci = (u & 7) | ((u >> 6) << 3), grp = h >> 2;
  const int R0 = ci * 128;
  int b, slot; chunk_info(ci, b, slot);
  float* wdt = (float*)lds;
  if (w < 2) {
    const int dir = w;
    const float A = -expf(p.ssd_A_log[l * 16 + dir * 8 + h]);
    float d0, d1, inc0, inc1, exc0, exc1, total;
    chunk_cumsum(dt, R0, dir * 8 + h, A, lane, d0, d1, inc0, inc1, exc0, exc1, total);
    float w0, w1;
    if (dir == 0) { w0 = fexp(total - inc0); w1 = fexp(total - inc1); }
    else { w0 = fexp(exc0); w1 = fexp(exc1); }
    wdt[dir * 128 + 2 * lane] = d0 * w0;
    wdt[dir * 128 + 2 * lane + 1] = d1 * w1;
    if (lane == 0) dec[((size_t)(b * 2 + dir) * NSLOT + slot) * 8 + h] = fexp(total);
  }
  {
    u32x4 xr[4];
#pragma unroll
    for (int q = 0; q < 4; ++q) {
      const int f = w * 4 + q, ks = f >> 2, pt = f & 3;
      xr[q] = *(const u32x4*)(P + xT_off(R0, h * 64 + pt * 16 + lr, ks * 32 + g4 * 8));
    }
#pragma unroll
    for (int q = 0; q < 4; ++q) *(u32x4*)(lds + 4096 + (w * 4 + q) * 1024 + lane * 16) = xr[q];
  }
  __syncthreads();
  bf16x8 bt[2][4];
#pragma unroll
  for (int i = 0; i < 2; ++i)
#pragma unroll
    for (int ks = 0; ks < 4; ++ks)
      bt[i][ks] = *(const bf16x8*)(BT + (size_t)(grp * 128 + w * 32 + i * 16 + lr) * NROWS + R0 + ks * 32 + g4 * 8);
  f32x4 af[2][4], ab[2][4];
#pragma unroll
  for (int i = 0; i < 2; ++i)
#pragma unroll
    for (int pt = 0; pt < 4; ++pt) { af[i][pt] = f32x4{0.f, 0.f, 0.f, 0.f}; ab[i][pt] = f32x4{0.f, 0.f, 0.f, 0.f}; }
#pragma unroll
  for (int ks = 0; ks < 4; ++ks) {
    const int tok = ks * 32 + g4 * 8;
    const f32x4 wf0 = *(const f32x4*)(wdt + tok), wf1 = *(const f32x4*)(wdt + tok + 4);
    const f32x4 wb0 = *(const f32x4*)(wdt + 128 + tok), wb1 = *(const f32x4*)(wdt + 128 + tok + 4);
#pragma unroll
    for (int pt = 0; pt < 4; ++pt) {
      const u32x4 raw = *(const u32x4*)(lds + 4096 + (ks * 4 + pt) * 1024 + lane * 16);
      u32x4 xf, xb;
      xf[0] = pack2(lo_f(raw[0]) * wf0[0], hi_f(raw[0]) * wf0[1]); xf[1] = pack2(lo_f(raw[1]) * wf0[2], hi_f(raw[1]) * wf0[3]);
      xf[2] = pack2(lo_f(raw[2]) * wf1[0], hi_f(raw[2]) * wf1[1]); xf[3] = pack2(lo_f(raw[3]) * wf1[2], hi_f(raw[3]) * wf1[3]);
      xb[0] = pack2(lo_f(raw[0]) * wb0[0], hi_f(raw[0]) * wb0[1]); xb[1] = pack2(lo_f(raw[1]) * wb0[2], hi_f(raw[1]) * wb0[3]);
      xb[2] = pack2(lo_f(raw[2]) * wb1[0], hi_f(raw[2]) * wb1[1]); xb[3] = pack2(lo_f(raw[3]) * wb1[2], hi_f(raw[3]) * wb1[3]);
#pragma unroll
      for (int i = 0; i < 2; ++i) {
        af[i][pt] = mfma16(bt[i][ks], as_bf8(xf), af[i][pt]);
        ab[i][pt] = mfma16(bt[i][ks], as_bf8(xb), ab[i][pt]);
      }
    }
  }
#pragma unroll
  for (int dir = 0; dir < 2; ++dir) {
    bfu* Sb = St + (((size_t)(b * 2 + dir) * NSLOT + slot) * 8 + h) * 8192;
#pragma unroll
    for (int i = 0; i < 2; ++i)
#pragma unroll
      for (int pt = 0; pt < 4; ++pt) {
        const f32x4 a = dir == 0 ? af[i][pt] : ab[i][pt];
        const int n = w * 32 + i * 16 + 4 * g4, pc = pt * 16 + lr;
        u32x2 o; o[0] = pack2(a[0], a[1]); o[1] = pack2(a[2], a[3]);
        *(u32x2*)(Sb + pc * 128 + n) = o;
      }
  }
  __syncthreads();
}

DI void phaseD2(const Params& p) {
  bfu* St = (bfu*)(ows(p) + OFF_ST);
  const float* dec = (const float*)(ows(p) + OFF_DEC);
  for (int gt = blockIdx.x * 256 + otid(); gt < 8 * 2 * 8 * 1024; gt += gridDim.x * 256) {
    const int e8 = gt & 1023, h = (gt >> 10) & 7, dir = (gt >> 13) & 1, b = gt >> 14;
    bfu* base = St + (size_t)(b * 2 + dir) * NSLOT * 65536 + h * 8192 + e8 * 8;
    const float* db = dec + (size_t)(b * 2 + dir) * NSLOT * 8 + h;
    float carry[8];
#pragma unroll
    for (int e = 0; e < 8; ++e) carry[e] = 0.f;
#pragma unroll 1
    for (int hb = 0; hb < 2; ++hb) {
      u32x4 raws[17];
      float dcys[17];
#pragma unroll
      for (int q = 0; q < 17; ++q) {
        const int step = hb * 17 + q;
        const int slot = (dir == 0) ? step : (step < 2 ? 1 - step : 35 - step);
        raws[q] = *(const u32x4*)(base + (size_t)slot * 65536);
        dcys[q] = db[slot * 8];
      }
#pragma unroll
      for (int q = 0; q < 17; ++q) {
        const int step = hb * 17 + q;
        const int slot = (dir == 0) ? step : (step < 2 ? 1 - step : 35 - step);
        u32x4 o;
#pragma unroll
        for (int e = 0; e < 4; ++e) o[e] = pack2(carry[2 * e], carry[2 * e + 1]);
        *(u32x4*)(base + (size_t)slot * 65536) = o;
#pragma unroll
        for (int e = 0; e < 4; ++e) {
          carry[2 * e] = carry[2 * e] * dcys[q] + lo_f(raws[q][e]);
          carry[2 * e + 1] = carry[2 * e + 1] * dcys[q] + hi_f(raws[q][e]);
        }
      }
    }
  }
}

DI void ssdy_unit(const Params& p, int l, int u, char* lds, bool dry = false) {
  bfu* P = (bfu*)(ows(p) + OFF_P);
  const float* dt = (const float*)(ows(p) + OFF_DT);
  const bfu* St = (const bfu*)(ows(p) + OFF_ST);
  float* ssq = (float*)(ows(p) + OFF_SS);
  const int tid = otid(), lane = tid & 63, w = tid >> 6, lr = lane & 15, g4 = lane >> 4;
  const int h = (u >> 3) & 7, ci = (u & 7) | ((u >> 6) << 3), grp = h >> 2;
  const int R0 = ci * 128;
  int b, slot; chunk_info(ci, b, slot);
  float* acf = (float*)(lds + 61440);
  float* rcb = acf + 128;
  float* dtf = acf + 256;
  float* dtb = acf + 384;
  if (w < 2) {
    const int dir = w;
    const float A = -expf(p.ssd_A_log[l * 16 + dir * 8 + h]);
    float d0, d1, inc0, inc1, exc0, exc1, total;
    chunk_cumsum(dt, R0, dir * 8 + h, A, lane, d0, d1, inc0, inc1, exc0, exc1, total);
    if (dir == 0) { acf[2 * lane] = inc0; acf[2 * lane + 1] = inc1; dtf[2 * lane] = d0; dtf[2 * lane + 1] = d1; }
    else { rcb[2 * lane] = total - exc0; rcb[2 * lane + 1] = total - exc1; dtb[2 * lane] = d0; dtb[2 * lane + 1] = d1; }
  }
  {
    u32x4 sreg[8];
#pragma unroll
    for (int q = 0; q < 8; ++q) {
      const int f = w * 8 + q, dir = f >> 4, pt = (f >> 2) & 3, ks = f & 3;
      const bfu* Sb = St + (((size_t)(b * 2 + dir) * NSLOT + slot) * 8 + h) * 8192;
      sreg[q] = *(const u32x4*)(Sb + (pt * 16 + lr) * 128 + ks * 32 + g4 * 8);
    }
#pragma unroll
    for (int q = 0; q < 8; ++q) *(u32x4*)(lds + (w * 8 + q) * 1024 + lane * 16) = sreg[q];
  }
  __syncthreads();
  const int l0 = w * 32;
  bf16x8 cf[2][4];
#pragma unroll
  for (int lt = 0; lt < 2; ++lt)
#pragma unroll
    for (int ks = 0; ks < 4; ++ks)
      cf[lt][ks] = *(const bf16x8*)(P + (size_t)(R0 + l0 + lt * 16 + lr) * PS + PC_GLU + 768 + grp * 128 + ks * 32 + g4 * 8);
  float al[2], rl[2];
#pragma unroll
  for (int lt = 0; lt < 2; ++lt) { al[lt] = acf[l0 + lt * 16 + lr]; rl[lt] = rcb[l0 + lt * 16 + lr]; }
  f32x4 yacc[2][4];
#pragma unroll
  for (int dir = 0; dir < 2; ++dir) {
    f32x4 tmp[2][4];
#pragma unroll
    for (int lt = 0; lt < 2; ++lt)
#pragma unroll
      for (int pt = 0; pt < 4; ++pt) tmp[lt][pt] = f32x4{0.f, 0.f, 0.f, 0.f};
#pragma unroll
    for (int pt = 0; pt < 4; ++pt)
#pragma unroll
      for (int ks = 0; ks < 4; ++ks) {
        const bf16x8 sf = *(const bf16x8*)(lds + (dir * 16 + pt * 4 + ks) * 1024 + lane * 16);
#pragma unroll
        for (int lt = 0; lt < 2; ++lt) tmp[lt][pt] = mfma16(sf, cf[lt][ks], tmp[lt][pt]);
      }
#pragma unroll
    for (int lt = 0; lt < 2; ++lt) {
      const float e = fexp(dir == 0 ? al[lt] : rl[lt]);
#pragma unroll
      for (int pt = 0; pt < 4; ++pt) {
        if (dir == 0) yacc[lt][pt] = tmp[lt][pt] * e;
        else yacc[lt][pt] += tmp[lt][pt] * e;
      }
    }
  }
  __syncthreads();
  {
    u32x4 breg[12];
#pragma unroll
    for (int j = 0; j < 8; ++j) {
      const int st = j >> 2, ks = j & 3;
      breg[j] = *(const u32x4*)(P + (size_t)(R0 + w * 32 + st * 16 + lr) * PS + PC_GLU + 512 + grp * 128 + ks * 32 + g4 * 8);
    }
#pragma unroll
    for (int pt = 0; pt < 4; ++pt) {
      const int ch = h * 64 + pt * 16 + lr;
      const bfu* xp = P + xT_off(R0, ch, w * 32 + 4 * g4);
      const u32x2 lo = *(const u32x2*)xp, hi = *(const u32x2*)(xp + 16);
      breg[8 + pt][0] = lo[0]; breg[8 + pt][1] = lo[1]; breg[8 + pt][2] = hi[0]; breg[8 + pt][3] = hi[1];
    }
#pragma unroll
    for (int j = 0; j < 12; ++j) *(u32x4*)(lds + (w * 12 + j) * 1024 + lane * 16) = breg[j];
  }
  __syncthreads();
#pragma unroll 1
  for (int sb = 0; sb < 4; ++sb) {
    const bool dof = sb <= w, dob = sb >= w;
    bf16x8 bfr[2][4];
#pragma unroll
    for (int st = 0; st < 2; ++st)
#pragma unroll
      for (int ks = 0; ks < 4; ++ks)
        bfr[st][ks] = *(const bf16x8*)(lds + (sb * 12 + st * 4 + ks) * 1024 + lane * 16);
    f32x4 acs[2], rcs[2], dfs[2], dbs[2];
#pragma unroll
    for (int st = 0; st < 2; ++st) {
      const int s0 = sb * 32 + st * 16 + 4 * g4;
      acs[st] = *(const f32x4*)(acf + s0); rcs[st] = *(const f32x4*)(rcb + s0);
      dfs[st] = *(const f32x4*)(dtf + s0); dbs[st] = *(const f32x4*)(dtb + s0);
    }
    bf16x8 xa[4];
#pragma unroll
    for (int pt = 0; pt < 4; ++pt) xa[pt] = *(const bf16x8*)(lds + (sb * 12 + 8 + pt) * 1024 + lane * 16);
#pragma unroll
    for (int lt = 0; lt < 2; ++lt) {
      f32x4 cb0 = f32x4{0.f, 0.f, 0.f, 0.f}, cb1 = f32x4{0.f, 0.f, 0.f, 0.f};
#pragma unroll
      for (int ks = 0; ks < 4; ++ks) { cb0 = mfma16(bfr[0][ks], cf[lt][ks], cb0); cb1 = mfma16(bfr[1][ks], cf[lt][ks], cb1); }
      const int lpos = l0 + lt * 16 + lr;
      const int sA = sb * 32 + 4 * g4, sB = sA + 16;
      if (dof) {
        float m[8];
#pragma unroll
        for (int r = 0; r < 4; ++r) {
          m[r] = (sA + r <= lpos) ? cb0[r] * fexp(al[lt] - acs[0][r]) * dfs[0][r] : 0.f;
          m[4 + r] = (sB + r <= lpos) ? cb1[r] * fexp(al[lt] - acs[1][r]) * dfs[1][r] : 0.f;
        }
        u32x4 pp; pp[0] = pack2(m[0], m[1]); pp[1] = pack2(m[2], m[3]); pp[2] = pack2(m[4], m[5]); pp[3] = pack2(m[6], m[7]);
#pragma unroll
        for (int pt = 0; pt < 4; ++pt) yacc[lt][pt] = mfma16(xa[pt], as_bf8(pp), yacc[lt][pt]);
      }
      if (dob) {
        float m[8];
#pragma unroll
        for (int r = 0; r < 4; ++r) {
          m[r] = (sA + r >= lpos) ? cb0[r] * fexp(rl[lt] - rcs[0][r]) * dbs[0][r] : 0.f;
          m[4 + r] = (sB + r >= lpos) ? cb1[r] * fexp(rl[lt] - rcs[1][r]) * dbs[1][r] : 0.f;
        }
        u32x4 pp; pp[0] = pack2(m[0], m[1]); pp[1] = pack2(m[2], m[3]); pp[2] = pack2(m[4], m[5]); pp[3] = pack2(m[6], m[7]);
#pragma unroll
        for (int pt = 0; pt < 4; ++pt) yacc[lt][pt] = mfma16(xa[pt], as_bf8(pp), yacc[lt][pt]);
      }
    }
  }
  const float Dh = p.ssd_D[l * 8 + h];
#pragma unroll
  for (int lt = 0; lt < 2; ++lt) {
    const int lpos = l0 + lt * 16 + lr;
    const size_t rowoff = (size_t)(R0 + lpos) * PS;
    float sq = 0.f;
#pragma unroll
    for (int pt = 0; pt < 4; ++pt) {
      const int p0 = pt * 16 + 4 * g4;
      bfu* zp = P + rowoff + PC_Z + h * 64 + p0;
      const u32x2 zr = *(const u32x2*)zp;
      const int tt = lpos & 31;
      const bfu* xl = (const bfu*)(lds + ((lpos >> 5) * 12 + 8 + pt) * 1024 + (((tt & 15) >> 2) * 16 + 4 * g4) * 16) + (tt & 3) + ((tt >> 4) << 2);
      float yv[4];
#pragma unroll
      for (int r = 0; r < 4; ++r) {
        const float xv = bf2f(xl[r * 8]);
        const float zv = (r & 1) ? hi_f(zr[r >> 1]) : lo_f(zr[r >> 1]);
        yv[r] = (yacc[lt][pt][r] + Dh * xv) * zv;
        sq += yv[r] * yv[r];
      }
      u32x2 o; o[0] = pack2(yv[0], yv[1]); o[1] = pack2(yv[2], yv[3]);
      if (!dry) *(u32x2*)zp = o;
    }
    sq += __shfl_xor(sq, 16);
    sq += __shfl_xor(sq, 32);
    if (g4 == 0 && !dry) ssq[(size_t)(R0 + lpos) * 8 + h] = sq;
  }
  __syncthreads();
}

DI void phaseG(const Params& p, int l, char* lds) {
  const bfu* Wg = (const bfu*)(ows(p) + OFF_WG) + (size_t)l * 3072 * 1024;
  const bfu* Wbr = (const bfu*)(ows(p) + OFF_WBR) + (size_t)l * 3 * 1024 * 512;
  const bfu* H = (const bfu*)(ows(p) + OFF_H);
  const bfu* P = (const bfu*)(ows(p) + OFF_P);
  const float* ssq = (const float*)(ows(p) + OFF_SS);
  bfu* Y = (bfu*)(ows(p) + OFF_ST);
  const int lane = otid() & 63, w = otid() >> 6, lr = lane & 15, g4 = lane >> 4, wn = w >> 1, wm = w & 1;
  const int nrows = (l == 0) ? NROWS : NLAT;
  const int MT = nrows / 128, MX = MT / 8;
  const int total = MT * 8;
  auto decode = [&](int u, int& tn, int& tm) {
    const int xcd = u & 7, j = u >> 3;
    tn = j & 7; tm = xcd * MX + (j >> 3);
  };
  if ((int)blockIdx.x < total) { int tn, tm; decode(blockIdx.x, tn, tm); gemm_prefetch(Wg + (size_t)(tn * 128) * 1024, 1024, H + (size_t)tm * 128 * 1024, 1024, lds); }
  for (int u = blockIdx.x; u < total; u += gridDim.x) {
    int tn, tm; decode(u, tn, tm);
    const int n0 = tn * 128, m0 = tm * 128;
    u32x2 y[4][4];
#pragma unroll
    for (int i = 0; i < 4; ++i)
#pragma unroll
      for (int j2 = 0; j2 < 4; ++j2) y[i][j2] = u32x2{0u, 0u};
#pragma unroll 1
    for (int br = 0; br < 3; ++br) {
      u32x2 gp[4][4];
      {
        f32x4 ga[4][4];
#pragma unroll
        for (int i = 0; i < 4; ++i)
#pragma unroll
          for (int j2 = 0; j2 < 4; ++j2) ga[i][j2] = f32x4{0.f, 0.f, 0.f, 0.f};
        gemm_core<4, false, true>(Wg + (size_t)(br * 1024 + n0) * 1024, 1024, H + (size_t)m0 * 1024, 1024, 1024, ga, lds);
        {
          const int ucol0 = (br == 0) ? PC_Q : (br == 1 ? PC_Z : PC_GCV);
          gemm_prefetch(Wbr + (size_t)(br * 1024 + n0) * 512, 512, P + (size_t)m0 * PS + ucol0, PS, lds);
        }
#pragma unroll
        for (int i = 0; i < 4; ++i) {
          const f32x4 bg = *(const f32x4*)(p.b_gate + (size_t)(l * 3 + br) * 1024 + n0 + wn * 64 + i * 16 + 4 * g4);
#pragma unroll
          for (int j2 = 0; j2 < 4; ++j2) {
            gp[i][j2][0] = pack2(sigmoidf_(ga[i][j2][0] + bg[0]), sigmoidf_(ga[i][j2][1] + bg[1]));
            gp[i][j2][1] = pack2(sigmoidf_(ga[i][j2][2] + bg[2]), sigmoidf_(ga[i][j2][3] + bg[3]));
          }
        }
      }
      f32x4 ua[4][4];
#pragma unroll
      for (int i = 0; i < 4; ++i)
#pragma unroll
        for (int j2 = 0; j2 < 4; ++j2) ua[i][j2] = f32x4{0.f, 0.f, 0.f, 0.f};
      const int ucol = (br == 0) ? PC_Q : (br == 1 ? PC_Z : PC_GCV);
      gemm_core<4, false, true>(Wbr + (size_t)(br * 1024 + n0) * 512, 512, P + (size_t)m0 * PS + ucol, PS, 512, ua, lds);
      if (br < 2) gemm_prefetch(Wg + (size_t)((br + 1) * 1024 + n0) * 1024, 1024, H + (size_t)m0 * 1024, 1024, lds);
      else if (u + (int)gridDim.x < total) { int tn2, tm2; decode(u + gridDim.x, tn2, tm2); gemm_prefetch(Wg + (size_t)(tn2 * 128) * 1024, 1024, H + (size_t)tm2 * 128 * 1024, 1024, lds); }
      float rs[4] = {1.f, 1.f, 1.f, 1.f};
      if (br == 1) {
#pragma unroll
        for (int j2 = 0; j2 < 4; ++j2) {
          const float* sp = ssq + (size_t)(m0 + wm * 64 + j2 * 16 + lr) * 8;
          const f32x4 s0 = *(const f32x4*)sp, s1 = *(const f32x4*)(sp + 4);
          const float sm = ((s0[0] + s0[1]) + (s0[2] + s0[3])) + ((s1[0] + s1[1]) + (s1[2] + s1[3]));
          rs[j2] = rsqrtf(sm * (1.f / 512.f) + EPS);
        }
      }
      if (!((KNOCK >> br) & 1)) {
#pragma unroll
        for (int i = 0; i < 4; ++i)
#pragma unroll
          for (int j2 = 0; j2 < 4; ++j2) {
            const float y0 = lo_f(y[i][j2][0]) + lo_f(gp[i][j2][0]) * ua[i][j2][0] * rs[j2];
            const float y1 = hi_f(y[i][j2][0]) + hi_f(gp[i][j2][0]) * ua[i][j2][1] * rs[j2];
            const float y2 = lo_f(y[i][j2][1]) + lo_f(gp[i][j2][1]) * ua[i][j2][2] * rs[j2];
            const float y3 = hi_f(y[i][j2][1]) + hi_f(gp[i][j2][1]) * ua[i][j2][3] * rs[j2];
            y[i][j2][0] = pack2(y0, y1); y[i][j2][1] = pack2(y2, y3);
          }
      }
    }
    {
      char* eb = epi_block_base(lds, w);
#pragma unroll
      for (int i = 0; i < 4; ++i)
#pragma unroll
        for (int j2 = 0; j2 < 4; ++j2) epi_put(eb, i, j2, lr, g4, y[i][j2][0], y[i][j2][1]);
      epi_flush(eb, lane, Y + (size_t)(m0 + wm * 64) * 1024 + n0 + wn * 64, 1024);
    }
  }
}

DI void phaseH(const Params& p, int l, char* lds, bool dry = false) {
  const bfu* Wout = (const bfu*)(ows(p) + OFF_WOUT) + (size_t)l * 1024 * 1024;
  const bfu* Y = (const bfu*)(ows(p) + OFF_ST);
  const float* mod = (const float*)(ows(p) + OFF_MOD);
  float* x1c = (float*)(ows(p) + OFF_X1C);
  const int lane = otid() & 63, w = otid() >> 6, lr = lane & 15, g4 = lane >> 4, wn = w >> 1, wm = w & 1;
  const int nrows = (l == 0) ? NROWS : NLAT;
  const int MT = nrows / 128, MX = MT / 8;
  const int total = MT * 8;
  auto decode = [&](int u, int& tn, int& tm) { const int xcd = u & 7, j = u >> 3; tn = j & 7; tm = xcd * MX + (j >> 3); };
  if ((int)blockIdx.x < total) { int tn, tm; decode(blockIdx.x, tn, tm); gemm_prefetch(Wout + (size_t)tn * 128 * 1024, 1024, Y + (size_t)tm * 128 * 1024, 1024, lds); }
  for (int u = blockIdx.x; u < total; u += gridDim.x) {
    int tn, tm; decode(u, tn, tm);
    const int n0 = tn * 128, m0 = tm * 128;
    f32x4 acc[4][4];
#pragma unroll
    for (int i = 0; i < 4; ++i)
#pragma unroll
      for (int j = 0; j < 4; ++j) acc[i][j] = f32x4{0.f, 0.f, 0.f, 0.f};
    gemm_core<4, false, true, true>(Wout + (size_t)n0 * 1024, 1024, Y + (size_t)m0 * 1024, 1024, 1024, acc, lds);
    if (u + (int)gridDim.x < total) { int tn2, tm2; decode(u + gridDim.x, tn2, tm2); gemm_prefetch(Wout + (size_t)tn2 * 128 * 1024, 1024, Y + (size_t)tm2 * 128 * 1024, 1024, lds); }
    const bool isctx = m0 >= NLAT;
    const int mrow = isctx ? 8 : (m0 >> 12);
    const float* gate = mod + (size_t)(l * 9 + mrow) * 3072 + 2048;
    const float* xres; float* xdst;
    if (!isctx) { xres = (l == 0) ? p.x : p.out; xdst = p.out; }
    else { xres = p.ctx - (size_t)NLAT * 1024; xdst = x1c - (size_t)NLAT * 1024; }
#pragma unroll
    for (int i = 0; i < 4; ++i) {
      const int n = n0 + wn * 64 + i * 16 + 4 * g4;
      const f32x4 gt = *(const f32x4*)(gate + n);
#pragma unroll
      for (int j = 0; j < 4; ++j) {
        const int m = m0 + wm * 64 + j * 16 + lr;
        const f32x4 xr = *(const f32x4*)(xres + (size_t)m * 1024 + n);
        f32x4 o;
#pragma unroll
        for (int r = 0; r < 4; ++r) o[r] = xr[r] + gt[r] * acc[i][j][r];
        if (!dry) *(f32x4*)(xdst + (size_t)m * 1024 + n) = o;
      }
    }
  }
}

DI void phaseFinal(const Params& p) {
  const int lane = otid() & 63;
  const int gw = blockIdx.x * 4 + (otid() >> 6), nw = gridDim.x * 4;
  for (int row = gw; row < NLAT; row += nw) {
    float* src = p.out + (size_t)row * 1024;
    f32x4 v[4];
    float ss = 0.f;
#pragma unroll
    for (int i = 0; i < 4; ++i) { v[i] = ((const f32x4*)src)[i * 64 + lane]; ss += v[i][0] * v[i][0] + v[i][1] * v[i][1] + v[i][2] * v[i][2] + v[i][3] * v[i][3]; }
    ss = wave_sum(ss);
    const float rstd = rsqrtf(ss * (1.f / 1024.f) + EPS);
#pragma unroll
    for (int i = 0; i < 4; ++i) {
      const f32x4 w4 = *(const f32x4*)(p.final_norm_w + (i * 64 + lane) * 4);
      f32x4 o;
#pragma unroll
      for (int r = 0; r < 4; ++r) o[r] = v[i][r] * rstd * w4[r];
      ((f32x4*)src)[i * 64 + lane] = o;
    }
  }
}

typedef const Params __attribute__((address_space(4)))* KArgPtr;
DI Params load_params() {
  KArgPtr q = (KArgPtr)__builtin_amdgcn_kernarg_segment_ptr();
  asm volatile("" : "+s"(q));
  Params r;
  r.x = q->x;
  r.c = q->c;
  r.ctx = q->ctx;
  r.c_ctx = q->c_ctx;
  r.w_mod = q->w_mod;
  r.b_mod = q->b_mod;
  r.norm_w = q->norm_w;
  r.w_in = q->w_in;
  r.q_norm_w = q->q_norm_w;
  r.k_norm_w = q->k_norm_w;
  r.ssd_conv_w = q->ssd_conv_w;
  r.ssd_conv_b = q->ssd_conv_b;
  r.ssd_A_log = q->ssd_A_log;
  r.ssd_dt_bias = q->ssd_dt_bias;
  r.ssd_D = q->ssd_D;
  r.ssd_norm_w = q->ssd_norm_w;
  r.cm_conv_w = q->cm_conv_w;
  r.cm_conv_b = q->cm_conv_b;
  r.cm_ln_w = q->cm_ln_w;
  r.cm_ln_b = q->cm_ln_b;
  r.b_gate = q->b_gate;
  r.w_out = q->w_out;
  r.final_norm_w = q->final_norm_w;
  r.out = q->out;
  r.ws = q->ws;
  r.w_br[0] = q->w_br[0]; r.w_br[1] = q->w_br[1]; r.w_br[2] = q->w_br[2];
  return r;
}

#define XB_TMO      128
#define XB_XCNT(j)  (256  + 64 * (j))
#define XB_XSUB(j)  (1280 + 64 * (j))
#define XB_XGEN(j)  (2304 + 64 * (j))
#define XB_TOP      3328
#define XB_TOPGEN   3392
#define XCD_BAR_WORDS 3456
#define XB_SPIN_CAP (1u << 18)
#define LAS __attribute__((address_space(3)))
DI unsigned xb_ld(unsigned* p)              { return __hip_atomic_load(p, __ATOMIC_RELAXED, __HIP_MEMORY_SCOPE_AGENT); }
DI unsigned xb_add(unsigned* p, unsigned v) { return __hip_atomic_fetch_add(p, v, __ATOMIC_RELAXED, __HIP_MEMORY_SCOPE_AGENT); }
DI unsigned xb_xcc_id() { return (unsigned)__builtin_amdgcn_s_getreg((3 << 11) | 20) & 0xFu; }
#define XB_SPIN(cond, bar) do { unsigned _sp = 0; while (cond) { __builtin_amdgcn_s_sleep(1); \
    if ((++_sp & 255u) == 0u) { if (xb_ld(&(bar)[XB_TMO])) break; if (_sp > XB_SPIN_CAP) { atomicAdd(&(bar)[XB_TMO], 1u); break; } } } } while (0)
struct XcdBarrier { unsigned* bar; unsigned x; volatile LAS unsigned* st; };
DI XcdBarrier xcd_barrier_post(unsigned* bar, volatile LAS unsigned* st) {
  XcdBarrier b; b.bar = bar; b.x = xb_xcc_id(); b.st = st;
  if (threadIdx.x == 0) (void)xb_add(&bar[XB_XCNT(b.x)], 1u);
  return b;
}
DI void xcd_barrier_complete(unsigned* bar, unsigned x, unsigned& nloc, unsigned& nx) {
  const unsigned G = gridDim.x * gridDim.y * gridDim.z;
  unsigned sum, cnt, mine, sp = 0u;
  for (;;) {
    sum = 0u; cnt = 0u; mine = 0u;
#pragma unroll
    for (unsigned j = 0; j < 16; ++j) { const unsigned c = xb_ld(&bar[XB_XCNT(j)]); sum += c; cnt += (c > 0u) ? 1u : 0u; mine = (j == x) ? c : mine; }
    if (sum == G) break;
    __builtin_amdgcn_s_sleep(1);
    if ((++sp & 255u) == 0u) { if (xb_ld(&bar[XB_TMO])) break; if (sp > XB_SPIN_CAP) { atomicAdd(&bar[XB_TMO], 1u); break; } }
  }
  nloc = mine > 0u ? mine : 1u; nx = cnt > 0u ? cnt : 1u;
}
DI void xcd_barrier(const XcdBarrier& b) {
  asm volatile("s_waitcnt vmcnt(0)" ::: "memory");
  __syncthreads();
  if (threadIdx.x == 0) {
    unsigned* bar = b.bar;
    __builtin_amdgcn_s_waitcnt(0);
    unsigned nloc = b.st[0], nx = b.st[1];
    if (nloc == 0u) { xcd_barrier_complete(bar, b.x, nloc, nx); b.st[0] = nloc; b.st[1] = nx; }
    const unsigned old = xb_add(&bar[XB_XSUB(b.x)], 1u);
    const unsigned gen = old / nloc;
    if (old + 1u == (gen + 1u) * nloc) {
      __builtin_amdgcn_fence(__ATOMIC_RELEASE, "agent");
      asm volatile("s_waitcnt vmcnt(0)" ::: "memory");
      const unsigned og = xb_add(&bar[XB_TOP], 1u);
      const unsigned tg = og / nx;
      if (og + 1u == (tg + 1u) * nx) xb_add(&bar[XB_TOPGEN], 1u);
      else XB_SPIN(xb_ld(&bar[XB_TOPGEN]) == tg, bar);
      __builtin_amdgcn_fence(__ATOMIC_ACQUIRE, "agent");
      xb_add(&bar[XB_XGEN(b.x)], 1u);
      asm volatile("s_waitcnt vmcnt(0)" ::: "memory");
    } else {
      XB_SPIN(xb_ld(&bar[XB_XGEN(b.x)]) == gen, bar);
      __builtin_amdgcn_fence(__ATOMIC_ACQUIRE, "agent");
      asm volatile("s_waitcnt vmcnt(0)" ::: "memory");
    }
  }
  __syncthreads();
}

#define lp load_params()
__global__ void __launch_bounds__(256, 2) hybrid_megakernel(Params p_unused) {
  __shared__ __attribute__((aligned(16))) char lds[65536];
  __shared__ uint4 xb_words;
  cg::grid_group grid = cg::this_grid();
  if (threadIdx.x == 0) xb_words = make_uint4(0u, 0u, 0u, 0u);
  __syncthreads();
  const XcdBarrier xb = xcd_barrier_post((unsigned*)(load_params().ws + OFF_BAR), (volatile LAS unsigned*)&xb_words);
  phase0(lp, lds);
  grid.sync();
#pragma unroll 1
  for (int l = 0; l < 2; ++l) {
    phaseA(lp, l);
    xcd_barrier(xb);
    if (REP == 8) { phaseA(lp, l); xcd_barrier(xb); phase0(lp, lds); xcd_barrier(xb); }
    phaseB(lp, l, lds);
    xcd_barrier(xb);
    if (REP == 1) { phaseB(lp, l, lds); xcd_barrier(xb); }
    if (REP == 5) { phaseC1(lp, l, lds, lp.out != nullptr); xcd_barrier(xb); }
    phaseC1(lp, l, lds);
    xcd_barrier(xb);
    if (REP == 3) { phaseC2(lp, l, lds, lp.out == nullptr ? false : true); xcd_barrier(xb); }
    phaseC2(lp, l, lds);
    xcd_barrier(xb);
    if (REP == 7) { for (int u = blockIdx.x; u < (NROWS / 128) * 8; u += gridDim.x) sloc_unit(lp, l, u, lds); xcd_barrier(xb); }
    if (REP == 9) { for (int i = 0; i < 10; ++i) xcd_barrier(xb); }
    for (int u = blockIdx.x; u < (NROWS / 128) * 8; u += gridDim.x) sloc_unit(lp, l, u, lds);
    xcd_barrier(xb);
    phaseD2(lp);
    xcd_barrier(xb);
    if (REP == 6) {
      const int ny = ((l == 0) ? NROWS / 128 : NLAT / 128) * 8;
      for (int u = blockIdx.x; u < ny; u += gridDim.x) ssdy_unit(lp, l, u, lds, lp.out != nullptr);
      xcd_barrier(xb);
    }
    {
      const int ny = ((l == 0) ? NROWS / 128 : NLAT / 128) * 8;
      for (int u = blockIdx.x; u < ny; u += gridDim.x) ssdy_unit(lp, l, u, lds);
    }
    xcd_barrier(xb);
    phaseG(lp, l, lds);
    xcd_barrier(xb);
    if (REP == 2) { phaseG(lp, l, lds); xcd_barrier(xb); }
    if (REP == 4) { phaseH(lp, l, lds, lp.out != nullptr); xcd_barrier(xb); }
    phaseH(lp, l, lds);
    xcd_barrier(xb);
  }
  phaseFinal(lp);
}

#undef lp
extern "C" void kernel_launch(void* const* d_in, const int* in_sizes, int n_in,
                              void* d_out, int out_size, void* d_ws, size_t ws_size,
                              hipStream_t stream) {
  static int grid_blocks = 0;
  if (!grid_blocks) {
    int dev = 0, cus = 0, per_cu = 0;
    (void)hipGetDevice(&dev);
    (void)hipDeviceGetAttribute(&cus, hipDeviceAttributeMultiprocessorCount, dev);
    (void)hipOccupancyMaxActiveBlocksPerMultiprocessor(&per_cu, hybrid_megakernel, 256, 0);
    if (per_cu > 2) per_cu = 2;
    if (per_cu < 1) per_cu = 1;
    grid_blocks = cus * per_cu;
  }
  Params p{};
  const float* const* in = (const float* const*)d_in;
  p.x = in[0]; p.c = in[1]; p.ctx = in[2]; p.c_ctx = in[3]; p.w_mod = in[4]; p.b_mod = in[5]; p.norm_w = in[6];
  p.w_in = in[7]; p.q_norm_w = in[8]; p.k_norm_w = in[9]; p.ssd_conv_w = in[10]; p.ssd_conv_b = in[11];
  p.ssd_A_log = in[12]; p.ssd_dt_bias = in[13]; p.ssd_D = in[14]; p.ssd_norm_w = in[15];
  p.cm_conv_w = in[16]; p.cm_conv_b = in[17]; p.cm_ln_w = in[18]; p.cm_ln_b = in[19];
  p.w_br[0] = in[20]; p.w_br[1] = in[21]; p.w_br[2] = in[22];
  p.b_gate = in[23]; p.w_out = in[24]; p.final_norm_w = in[25];
  p.out = (float*)d_out;
  p.ws = (char*)d_ws;
  (void)hipMemsetAsync((char*)d_ws + OFF_BAR, 0, SZ_BAR, stream);
  void* args[] = {&p};
  (void)hipLaunchCooperativeKernel((void*)hybrid_megakernel, dim3(grid_blocks), dim3(256), args, 0, stream);
}
```

```cpp
#include <hip/hip_runtime.h>
#include <hip/hip_cooperative_groups.h>
namespace cg = cooperative_groups;

#define DI __device__ __forceinline__
typedef unsigned short bfu;
typedef __attribute__((ext_vector_type(8))) short bf16x8;
typedef __attribute__((ext_vector_type(4))) float f32x4;
typedef __attribute__((ext_vector_type(4))) unsigned u32x4;
typedef __attribute__((ext_vector_type(2))) unsigned u32x2;

constexpr int DM = 1024;
constexpr int NLAT = 32768;
constexpr int NROWS = 34816;
constexpr int PS = 4352;
constexpr int INC = 7440;
constexpr int PC_Q = 0, PC_K = 512, PC_V = 640, PC_GA = 768, PC_XBC = 1280, PC_Z = 2304,
              PC_GLU = 2816, PC_GCV = 3840;
constexpr int NKEY = 4352;
constexpr float EPS = 1e-6f;
constexpr float QSCALE = 0.125f * 1.4426950408889634f;
constexpr float LOG2E = 1.4426950408889634f;
constexpr int NSLOT = 34;
#ifndef REP
#define REP 0
#endif
#ifndef KNOCK
#define KNOCK 0
#endif

constexpr size_t OFF_WIN = 0;
constexpr size_t SZ_WIN = (size_t)2 * 4480 * 1024 * 2;
constexpr size_t OFF_WG = OFF_WIN + SZ_WIN;
constexpr size_t SZ_WG = (size_t)2 * 3072 * 1024 * 2;
constexpr size_t OFF_WBR = OFF_WG + SZ_WG;
constexpr size_t SZ_WBR = (size_t)2 * 3 * 1024 * 512 * 2;
constexpr size_t OFF_WOUT = OFF_WBR + SZ_WBR;
constexpr size_t SZ_WOUT = (size_t)2 * 1024 * 1024 * 2;
constexpr size_t OFF_MOD = OFF_WOUT + SZ_WOUT;
constexpr size_t SZ_MOD = (size_t)2 * 9 * 3072 * 4;
constexpr size_t OFF_H = OFF_MOD + SZ_MOD;
constexpr size_t SZ_H = (size_t)NROWS * 1024 * 2;
constexpr size_t OFF_P = OFF_H + SZ_H;
constexpr size_t SZ_P = (size_t)NROWS * PS * 2;
constexpr size_t OFF_DT = OFF_P + SZ_P;
constexpr size_t SZ_DT = (size_t)NROWS * 16 * 4;
constexpr size_t OFF_KP = OFF_DT + SZ_DT;
constexpr size_t SZ_KP = (size_t)8 * 2 * NKEY * 64 * 2;
constexpr size_t OFF_VT = OFF_KP + SZ_KP;
constexpr size_t OFF_ST = OFF_VT + SZ_KP;
constexpr size_t SZ_ST = (size_t)8 * 2 * NSLOT * 8 * 8192 * 2;
constexpr size_t OFF_DEC = OFF_ST + SZ_ST;
constexpr size_t SZ_DEC = (size_t)8 * 2 * NSLOT * 8 * 4;
constexpr size_t OFF_SS = OFF_DEC + SZ_DEC;
constexpr size_t SZ_SS = (size_t)NROWS * 8 * 4;
constexpr size_t OFF_X1C = OFF_SS + SZ_SS;
constexpr size_t SZ_X1C = (size_t)2048 * 1024 * 4;
constexpr size_t OFF_BT = OFF_X1C + SZ_X1C;
constexpr size_t SZ_BT = (size_t)256 * NROWS * 2;
constexpr size_t OFF_BAR = OFF_BT + SZ_BT;
constexpr size_t SZ_BAR = (size_t)3456 * 4;
constexpr size_t OFF_ROPE = OFF_BAR + ((SZ_BAR + 255) / 256) * 256;
constexpr size_t SZ_ROPE = (size_t)64 * 16 * 2 * 4;
constexpr size_t WS_TOTAL = OFF_ROPE + SZ_ROPE;
static_assert(WS_TOTAL <= (size_t)512 * 1024 * 1024, "workspace too large");
static_assert(SZ_ST == (size_t)NROWS * 1024 * 2, "ybuf alias size");

struct Params {
  const float *x, *c, *ctx, *c_ctx, *w_mod, *b_mod, *norm_w, *w_in, *q_norm_w, *k_norm_w;
  const float *ssd_conv_w, *ssd_conv_b, *ssd_A_log, *ssd_dt_bias, *ssd_D, *ssd_norm_w;
  const float *cm_conv_w, *cm_conv_b, *cm_ln_w, *cm_ln_b;
  const float *w_br[3];
  const float *b_gate, *w_out, *final_norm_w;
  float* out;
  char* ws;
};

DI char* ows(const Params& p) {
  const unsigned long long v = (unsigned long long)p.ws;
  unsigned lo = __builtin_amdgcn_readfirstlane((unsigned)v), hi = __builtin_amdgcn_readfirstlane((unsigned)(v >> 32));
  asm volatile("" : "+s"(lo), "+s"(hi));
  return (char*)(((unsigned long long)hi << 32) | lo);
}
DI bfu f2bf(float x) { unsigned u = __float_as_uint(x); u += 0x7fffu + ((u >> 16) & 1u); return (bfu)(u >> 16); }
DI float bf2f(unsigned b) { return __uint_as_float(b << 16); }
typedef __bf16 hbf16x2 __attribute__((ext_vector_type(2)));
typedef float f32x2 __attribute__((ext_vector_type(2)));
DI unsigned pack2(float a, float b) { f32x2 v = {a, b}; return __builtin_bit_cast(unsigned, __builtin_convertvector(v, hbf16x2)); }
DI float lo_f(unsigned w) { return __uint_as_float(w << 16); }
DI float hi_f(unsigned w) { return __uint_as_float(w & 0xffff0000u); }
DI float fexp2(float x) { return __builtin_amdgcn_exp2f(x); }
DI float fexp(float x) { return __builtin_amdgcn_exp2f(x * LOG2E); }
DI float frcp(float x) { return __builtin_amdgcn_rcpf(x); }
DI float sigmoidf_(float x) { return frcp(1.f + fexp(-x)); }
DI float siluf_(float x) { return x * sigmoidf_(x); }
DI f32x4 mfma16(bf16x8 a, bf16x8 b, f32x4 c) { return __builtin_amdgcn_mfma_f32_16x16x32_bf16(a, b, c, 0, 0, 0); }
DI bf16x8 as_bf8(u32x4 v) { return __builtin_bit_cast(bf16x8, v); }
DI float wave_sum(float v) {
#pragma unroll
  for (int o = 32; o >= 1; o >>= 1) v += __shfl_xor(v, o);
  return v;
}
DI int swz(int row) { return (-(row >> 2)) & 3; }
DI int otid() { int t = threadIdx.x; asm volatile("" : "+v"(t)); return t; }

DI void cvt_tile(const float* __restrict__ src, int src_ld, int src_col0, int nvalid, int k0,
                 bfu* __restrict__ dst, int dst_ld, const float* __restrict__ kscale, float* lds, int src_col1 = -1) {
  const int tid = otid();
  const int c = tid & 63, r0 = tid >> 6;
  const int scol = (src_col1 >= 0 && c >= 32) ? src_col1 + (c - 32) : src_col0 + c;
  float tv[16];
#pragma unroll
  for (int i = 0; i < 16; ++i) {
    const int kk = r0 + i * 4;
    tv[i] = (c < nvalid) ? src[(size_t)(k0 + kk) * src_ld + scol] : 0.f;
  }
#pragma unroll
  for (int i = 0; i < 16; ++i) {
    const int kk = r0 + i * 4;
    float v = tv[i];
    if (kscale) v *= kscale[k0 + kk];
    lds[c * 65 + kk] = v;
  }
  __syncthreads();
  const int n = tid >> 2, kb = (tid & 3) * 16;
  u32x4 o0, o1;
#pragma unroll
  for (int j = 0; j < 4; ++j) {
    o0[j] = pack2(lds[n * 65 + kb + 2 * j], lds[n * 65 + kb + 2 * j + 1]);
    o1[j] = pack2(lds[n * 65 + kb + 8 + 2 * j], lds[n * 65 + kb + 8 + 2 * j + 1]);
  }
  u32x4* d = (u32x4*)(dst + (size_t)n * dst_ld + k0 + kb);
  d[0] = o0; d[1] = o1;
  __syncthreads();
}

DI void phase0(const Params& p, char* lds) {
  bfu* Win = (bfu*)(ows(p) + OFF_WIN);
  bfu* Wg = (bfu*)(ows(p) + OFF_WG);
  bfu* Wbr = (bfu*)(ows(p) + OFF_WBR);
  bfu* Wout = (bfu*)(ows(p) + OFF_WOUT);
  float* mod = (float*)(ows(p) + OFF_MOD);
  constexpr int T_IN = 118 * 16, T_BR = 384, T_OUT = 256, T_L = T_IN + T_BR + T_OUT;
  constexpr int N_MOD = 96;
  const int total = N_MOD + 2 * T_L;
  if (blockIdx.x == 0) {
    float* cs = (float*)(ows(p) + OFF_ROPE);
    for (int i = otid(); i < 1024; i += 256) {
      const int pos = i >> 4, f = i & 15;
      const float inv = powf(10000.f, -(float)f / 16.f);
      const float ang = (float)pos * inv;
      cs[i * 2] = cosf(ang); cs[i * 2 + 1] = sinf(ang);
    }
  }
  for (int u = blockIdx.x; u < total; u += gridDim.x) {
    if (u < N_MOD) {
      const int l = u / 48, j0 = (u % 48) * 64;
      float* sc = (float*)lds;
      float* red = sc + 9 * 1024;
      for (int i = otid(); i < 9 * 1024; i += 256) {
        int r = i >> 10, k = i & 1023;
        float v = (r < 8) ? p.c[r * 1024 + k] : p.c_ctx[k];
        sc[i] = v / (1.f + expf(-v));
      }
      __syncthreads();
      const int w = otid() >> 6, lane = otid() & 63;
      float acc[9];
#pragma unroll
      for (int r = 0; r < 9; ++r) acc[r] = 0.f;
      const float* wm = p.w_mod + (size_t)l * 1024 * 3072 + j0 + lane;
#pragma unroll 1
      for (int kb = w * 256; kb < w * 256 + 256; kb += 32) {
        float wv[32];
#pragma unroll
        for (int q = 0; q < 32; ++q) wv[q] = wm[(size_t)(kb + q) * 3072];
#pragma unroll
        for (int q = 0; q < 32; ++q)
#pragma unroll
          for (int r = 0; r < 9; ++r) acc[r] += sc[r * 1024 + kb + q] * wv[q];
      }
#pragma unroll
      for (int r = 0; r < 9; ++r) red[(w * 9 + r) * 64 + lane] = acc[r];
      __syncthreads();
      for (int i = otid(); i < 9 * 64; i += 256) {
        int r = i >> 6, ln = i & 63;
        float s = red[(0 * 9 + r) * 64 + ln] + red[(1 * 9 + r) * 64 + ln] + red[(2 * 9 + r) * 64 + ln] + red[(3 * 9 + r) * 64 + ln];
        mod[(size_t)(l * 9 + r) * 3072 + j0 + ln] = s + p.b_mod[l * 3072 + j0 + ln];
      }
      __syncthreads();
    } else {
      int v = u - N_MOD;
      const int l = v / T_L; v -= l * T_L;
      if (v < T_IN) {
        const int nt = v >> 4, kt = v & 15, n0 = nt * 64;
        const float* src = p.w_in + (size_t)l * 1024 * INC;
        if (n0 < 4480) {
          int col0, nvalid = 64;
          int col1 = -1;
          if (n0 < 2304) col0 = n0; else if (n0 < 4352) col0 = n0 + 16; else if (n0 == 4352) { col0 = 2304; nvalid = 16; } else { col0 = 0; nvalid = 0; }
          if (n0 >= PC_GLU && n0 < PC_GLU + 1024) { const int q = (n0 - PC_GLU) >> 6; col0 = 2832 + q * 32; col1 = 3344 + q * 32; }
          cvt_tile(src, INC, col0, nvalid, kt * 64, Win + ((size_t)l * 4480 + n0) * 1024, 1024, nullptr, (float*)lds, col1);
        } else {
          int j0 = n0 - 4480;
          cvt_tile(src, INC, 4368 + j0, 64, kt * 64, Wg + ((size_t)l * 3072 + j0) * 1024, 1024, nullptr, (float*)lds);
        }
      } else if (v < T_IN + T_BR) {
        int w = v - T_IN;
        const int br = w >> 7, nt = (w & 127) >> 3, kt = w & 7;
        const float *sb0 = p.w_br[0], *sb1 = p.w_br[1], *sb2 = p.w_br[2];
        asm volatile("" : "+s"(sb0), "+s"(sb1), "+s"(sb2));
        const float* src = (br == 0 ? sb0 : (br == 1 ? sb1 : sb2)) + (size_t)l * 512 * 1024;
        cvt_tile(src, 1024, nt * 64, 64, kt * 64, Wbr + ((size_t)(l * 3 + br) * 1024 + nt * 64) * 512, 512,
                 br == 1 ? p.ssd_norm_w + l * 512 : nullptr, (float*)lds);
      } else {
        int w = v - T_IN - T_BR;
        const int nt = w >> 4, kt = w & 15;
        cvt_tile(p.w_out + (size_t)l * 1024 * 1024, 1024, nt * 64, 64, kt * 64, Wout + ((size_t)l * 1024 + nt * 64) * 1024, 1024, nullptr, (float*)lds);
      }
    }
  }
}

DI void phaseA(const Params& p, int l) {
  const float* mod = (const float*)(ows(p) + OFF_MOD);
  bfu* H = (bfu*)(ows(p) + OFF_H);
  const float* xlat = (l == 0) ? p.x : p.out;
  const float* xctx = (l == 0) ? p.ctx : (const float*)(ows(p) + OFF_X1C);
  const int lane = otid() & 63;
  const int gw = blockIdx.x * 4 + (otid() >> 6), nw = gridDim.x * 4;
  const float* nwp = p.norm_w + l * 1024;
  for (int row = gw; row < NROWS; row += nw) {
    const float* src = (row < NLAT) ? xlat + (size_t)row * 1024 : xctx + (size_t)(row - NLAT) * 1024;
    const int mrow = (row < NLAT) ? (row >> 12) : 8;
    const float* md = mod + (size_t)(l * 9 + mrow) * 3072;
    f32x4 v[4];
    float ss = 0.f;
#pragma unroll
    for (int i = 0; i < 4; ++i) { v[i] = ((const f32x4*)src)[i * 64 + lane]; ss += v[i][0] * v[i][0] + v[i][1] * v[i][1] + v[i][2] * v[i][2] + v[i][3] * v[i][3]; }
    ss = wave_sum(ss);
    const float rstd = rsqrtf(ss * (1.f / 1024.f) + EPS);
#pragma unroll
    for (int i = 0; i < 4; ++i) {
      const int idx = (i * 64 + lane) * 4;
      f32x4 w4 = *(const f32x4*)(nwp + idx), sh = *(const f32x4*)(md + idx), sc = *(const f32x4*)(md + 1024 + idx);
      float o0 = v[i][0] * rstd * w4[0] * (1.f + sc[0]) + sh[0];
      float o1 = v[i][1] * rstd * w4[1] * (1.f + sc[1]) + sh[1];
      float o2 = v[i][2] * rstd * w4[2] * (1.f + sc[2]) + sh[2];
      float o3 = v[i][3] * rstd * w4[3] * (1.f + sc[3]) + sh[3];
      u32x2 o; o[0] = pack2(o0, o1); o[1] = pack2(o2, o3);
      *(u32x2*)(H + (size_t)row * 1024 + idx) = o;
    }
  }
}

#define GLDS16(gp, lp) __builtin_amdgcn_global_load_lds((const unsigned*)(gp), (unsigned*)(lp), 16, 0, 0)
#define WAIT_VM0() asm volatile("s_waitcnt vmcnt(0)" ::: "memory")
#define RAW_BARRIER() do { asm volatile("s_waitcnt lgkmcnt(0)" ::: "memory"); __builtin_amdgcn_s_barrier(); } while (0)
DI void gemm_prefetch(const bfu* __restrict__ W, int ldw, const bfu* __restrict__ A, int lda, char* lds) {
  const int tid = otid(), lane = tid & 63, w = tid >> 6;
  const int grow = lane >> 2;
  const int gch = ((lane & 3) ^ swz(grow)) * 8;
  const bfu* wsrc0 = W + (size_t)(w * 32 + grow) * ldw + gch;
  const bfu* wsrc1 = W + (size_t)(w * 32 + 16 + grow) * ldw + gch;
  const bfu* asrc0 = A + (size_t)(w * 32 + grow) * lda + gch;
  const bfu* asrc1 = A + (size_t)(w * 32 + 16 + grow) * lda + gch;
  char* sw = lds;
  char* sa = sw + 16384;
  GLDS16(wsrc0, sw + (w * 2) * 1024);
  GLDS16(wsrc1, sw + (w * 2 + 1) * 1024);
  GLDS16(wsrc0 + 32, sw + 8192 + (w * 2) * 1024);
  GLDS16(wsrc1 + 32, sw + 8192 + (w * 2 + 1) * 1024);
  GLDS16(asrc0, sa + (w * 2) * 1024);
  GLDS16(asrc1, sa + (w * 2 + 1) * 1024);
  GLDS16(asrc0 + 32, sa + 8192 + (w * 2) * 1024);
  GLDS16(asrc1 + 32, sa + 8192 + (w * 2 + 1) * 1024);
}
template <int NJ, bool LOWREG = false, bool PRE = false, bool PIPE = false>
DI void gemm_core(const bfu* __restrict__ W, int ldw, const bfu* __restrict__ A, int lda, int K,
                  f32x4 (&acc)[4][NJ], char* lds) {
  constexpr int ASLAB = NJ * 32 * 64;
  constexpr int STAGE = 16384 + 2 * ASLAB;
  const int tid = otid(), lane = tid & 63, w = tid >> 6;
  const int lr = lane & 15, g4 = lane >> 4;
  const int wn = w >> 1, wm = w & 1;
  const int grow = lane >> 2;
  const int gch = ((lane & 3) ^ swz(grow)) * 8;
  const bfu* wsrc0 = W + (size_t)(w * 32 + grow) * ldw + gch;
  const bfu* wsrc1 = W + (size_t)(w * 32 + 16 + grow) * ldw + gch;
  const bfu* asrc0 = A + (size_t)((NJ == 4 ? w * 32 : w * 16) + grow) * lda + gch;
  const bfu* asrc1 = A + (size_t)(w * 32 + 16 + grow) * lda + gch;
  auto issue = [&](int st, int k0) {
    char* sw = lds + st * STAGE;
    char* sa = sw + 16384;
    GLDS16(wsrc0 + k0, sw + (w * 2) * 1024);
    GLDS16(wsrc1 + k0, sw + (w * 2 + 1) * 1024);
    GLDS16(wsrc0 + k0 + 32, sw + 8192 + (w * 2) * 1024);
    GLDS16(wsrc1 + k0 + 32, sw + 8192 + (w * 2 + 1) * 1024);
    if (NJ == 4) {
      GLDS16(asrc0 + k0, sa + (w * 2) * 1024);
      GLDS16(asrc1 + k0, sa + (w * 2 + 1) * 1024);
      GLDS16(asrc0 + k0 + 32, sa + ASLAB + (w * 2) * 1024);
      GLDS16(asrc1 + k0 + 32, sa + ASLAB + (w * 2 + 1) * 1024);
    } else {
      GLDS16(asrc0 + k0, sa + w * 1024);
      GLDS16(asrc0 + k0 + 32, sa + ASLAB + w * 1024);
    }
  };
  const int fsw = (g4 ^ swz(lr)) * 16;
  const int nk = K >> 6;
  if (!PRE) issue(0, 0);
  WAIT_VM0();
  RAW_BARRIER();
  for (int kt = 0; kt < nk; ++kt) {
    const int cur = kt & 1;
    if (kt + 1 < nk) issue(cur ^ 1, (kt + 1) << 6);
    const char* sw = lds + cur * STAGE;
    const char* sa = sw + 16384;
    auto kstep = [&](int s) {
      bf16x8 af[4], bfr[NJ];
#pragma unroll
      for (int i = 0; i < 4; ++i) af[i] = *(const bf16x8*)(sw + s * 8192 + (wn * 64 + i * 16 + lr) * 64 + fsw);
#pragma unroll
      for (int j = 0; j < NJ; ++j) bfr[j] = *(const bf16x8*)(sa + s * ASLAB + (wm * (NJ * 16) + j * 16 + lr) * 64 + fsw);
#pragma unroll
      for (int i = 0; i < 4; ++i)
#pragma unroll
        for (int j = 0; j < NJ; ++j) acc[i][j] = mfma16(af[i], bfr[j], acc[i][j]);
    };
    if (LOWREG) {
#pragma unroll 1
      for (int s = 0; s < 2; ++s) kstep(s);
    } else if (NJ == 4 && PIPE) {
      bf16x8 a0[4], b0[4], a1[4], b1[4];
#pragma unroll
      for (int i = 0; i < 4; ++i) a0[i] = *(const bf16x8*)(sw + (wn * 64 + i * 16 + lr) * 64 + fsw);
#pragma unroll
      for (int j = 0; j < 4; ++j) b0[j] = *(const bf16x8*)(sa + (wm * 64 + j * 16 + lr) * 64 + fsw);
#pragma unroll
      for (int i = 0; i < 4; ++i) a1[i] = *(const bf16x8*)(sw + 8192 + (wn * 64 + i * 16 + lr) * 64 + fsw);
#pragma unroll
      for (int j = 0; j < 4; ++j) b1[j] = *(const bf16x8*)(sa + ASLAB + (wm * 64 + j * 16 + lr) * 64 + fsw);
      __builtin_amdgcn_sched_barrier(0);
#pragma unroll
      for (int i = 0; i < 4; ++i)
#pragma unroll
        for (int j = 0; j < 4; ++j) acc[i][j] = mfma16(a0[i], b0[j], acc[i][j]);
#pragma unroll
      for (int i = 0; i < 4; ++i)
#pragma unroll
        for (int j = 0; j < 4; ++j) acc[i][j] = mfma16(a1[i], b1[j], acc[i][j]);
    } else {
      kstep(0); kstep(1);
    }
    if (PIPE) __builtin_amdgcn_sched_barrier(0);
    WAIT_VM0();
    RAW_BARRIER();
  }
}


DI char* epi_block_base(char* lds, int w) { return lds + 32768 + (2 * w) * 1024; }
DI void epi_put(char* eb, int i, int j, int lr, int g4, unsigned v0, unsigned v1) {
  const int row = j * 16 + lr;
  const int c = i * 2 + (g4 >> 1);
  char* a = eb + (row >> 4) * 8192 + ((row >> 3) & 1) * 1024 + (row & 7) * 128 + ((c ^ (row & 7)) * 16) + (g4 & 1) * 8;
  u32x2 v; v[0] = v0; v[1] = v1;
  *(u32x2*)a = v;
}
DI void epi_flush(const char* eb, int lane, bfu* dst  , size_t ld) {
#pragma unroll
  for (int ps = 0; ps < 8; ++ps) {
    const int row = ps * 8 + (lane >> 3), c = lane & 7;
    const u32x4 v = *(const u32x4*)(eb + (row >> 4) * 8192 + ((row >> 3) & 1) * 1024 + (row & 7) * 128 + ((c ^ (row & 7)) * 16));
    *(u32x4*)(dst + (size_t)row * ld + c * 8) = v;
  }
}

DI void g256_issue(const bfu* __restrict__ W, int ldw, const bfu* __restrict__ A, int lda, int k0, char* buf) {
  const int tid = otid(), lane = tid & 63, w = tid >> 6;
  const int grow = lane >> 2;
  const int gch = ((lane & 3) ^ swz(grow)) * 8;
  const bfu* wsrc = W + (size_t)(w * 32 + grow) * ldw + k0 + gch;
  const bfu* asrc = A + (size_t)(w * 64 + grow) * lda + k0 + gch;
  char* sw = buf + (w * 2) * 1024;
  char* sa = buf + 16384 + (w * 4) * 1024;
#pragma unroll
  for (int sl = 0; sl < 2; ++sl) {
    GLDS16(wsrc + sl * 32, sw + sl * 8192);
    GLDS16(wsrc + sl * 32 + (size_t)16 * ldw, sw + sl * 8192 + 1024);
    GLDS16(asrc + sl * 32, sa + sl * 16384);
    GLDS16(asrc + sl * 32 + (size_t)16 * lda, sa + sl * 16384 + 1024);
    GLDS16(asrc + sl * 32 + (size_t)32 * lda, sa + sl * 16384 + 2048);
    GLDS16(asrc + sl * 32 + (size_t)48 * lda, sa + sl * 16384 + 3072);
  }
}
DI void g256_prefetch(const bfu* __restrict__ W, int ldw, const bfu* __restrict__ A, int lda, char* lds) { g256_issue(W, ldw, A, lda, 0, lds); }
DI void g256_core(const bfu* __restrict__ W, int ldw, const bfu* __restrict__ A, int lda, int K, f32x4 (&acc)[4][8], char* lds) {
  const int tid = otid(), lane = tid & 63, w = tid >> 6;
  const int lr = lane & 15, g4 = lane >> 4;
  const int wn = w >> 1, wm = w & 1;
  const int fsw = (g4 ^ swz(lr)) * 16;
  const int nk = K >> 6;
  const char* sw = lds + (wn * 64 + lr) * 64 + fsw;
  const char* sa = lds + 16384 + (wm * 128 + lr) * 64 + fsw;
  for (int kt = 0; kt < nk; ++kt) {
    WAIT_VM0();
    RAW_BARRIER();
#pragma unroll
    for (int sl = 0; sl < 2; ++sl) {
      bf16x8 af[4];
#pragma unroll
      for (int i = 0; i < 4; ++i) af[i] = *(const bf16x8*)(sw + sl * 8192 + i * 1024);
#pragma unroll
      for (int jh = 0; jh < 2; ++jh) {
        bf16x8 bfr[4];
#pragma unroll
        for (int j = 0; j < 4; ++j) bfr[j] = *(const bf16x8*)(sa + sl * 16384 + (jh * 4 + j) * 1024);
#pragma unroll
        for (int i = 0; i < 4; ++i)
#pragma unroll
          for (int j = 0; j < 4; ++j) acc[i][jh * 4 + j] = mfma16(af[i], bfr[j], acc[i][jh * 4 + j]);
      }
    }
    RAW_BARRIER();
    if (kt + 1 < nk) g256_issue(W, ldw, A, lda, (kt + 1) << 6, lds);
  }
}
DI void epi2_put(char* buf, int i, int jj, int lr, int g4, unsigned v0, unsigned v1) {
  const int row = jj * 16 + lr, c = i * 2 + (g4 >> 1);
  u32x2 v; v[0] = v0; v[1] = v1;
  *(u32x2*)(buf + row * 128 + ((c ^ (row & 7)) * 16) + (g4 & 1) * 8) = v;
}
DI void epi2_flush(const char* buf, int lane, bfu* dst, size_t ld) {
#pragma unroll
  for (int ps = 0; ps < 4; ++ps) {
    const int row = ps * 8 + (lane >> 3), c = lane & 7;
    const u32x4 v = *(const u32x4*)(buf + row * 128 + ((c ^ (row & 7)) * 16));
    *(u32x4*)(dst + (size_t)row * ld + c * 8) = v;
  }
}

DI void phaseB(const Params& p, int l, char* lds) {
  const bfu* Win = (const bfu*)(ows(p) + OFF_WIN) + (size_t)l * 4480 * 1024;
  const bfu* H = (const bfu*)(ows(p) + OFF_H);
  bfu* P = (bfu*)(ows(p) + OFF_P);
  float* dtraw = (float*)(ows(p) + OFF_DT);
  const int lane = otid() & 63, w = otid() >> 6, lr = lane & 15, g4 = lane >> 4, wn = w >> 1, wm = w & 1;
  constexpr int NT = 35;
  const int MT = (l == 0) ? NROWS / 256 : NLAT / 256, MX = MT / 8;
  const int nmain = NT * MT;
  const int total = (l == 0) ? nmain : nmain + 8 * 11;
  auto decode = [&](int u, int& tn, int& tm) {
    if (u >= nmain) {
      const int c = u - nmain, q = c % 11;
      tm = NLAT / 256 + c / 11;
      tn = (q < 2) ? 4 + q : (q < 10 ? 8 + q : 34);
      return;
    }
    const int xcd = u & 7, j = u >> 3;
    int tml;
    if (j < 4 * 8 * MX) { const int strip = j / (8 * MX), r = j % (8 * MX); tml = r >> 3; tn = strip * 8 + (r & 7); }
    else { const int r = j - 4 * 8 * MX; tml = r / 3; tn = 32 + r % 3; }
    tm = xcd * MX + tml;
  };
  if ((int)blockIdx.x < total) { int tn, tm; decode(blockIdx.x, tn, tm); g256_prefetch(Win + (size_t)tn * 128 * 1024, 1024, H + (size_t)tm * 256 * 1024, 1024, lds); }
  for (int u = blockIdx.x; u < total; u += gridDim.x) {
    int tn, tm; decode(u, tn, tm);
    const int n0 = tn * 128, m0 = tm * 256;
    f32x4 acc[4][8];
#pragma unroll
    for (int i = 0; i < 4; ++i)
#pragma unroll
      for (int j = 0; j < 8; ++j) acc[i][j] = f32x4{0.f, 0.f, 0.f, 0.f};
    g256_core(Win + (size_t)n0 * 1024, 1024, H + (size_t)m0 * 1024, 1024, 1024, acc, lds);
    if (u + (int)gridDim.x < total) { int tn2, tm2; decode(u + gridDim.x, tn2, tm2); g256_prefetch(Win + (size_t)tn2 * 128 * 1024, 1024, H + (size_t)tm2 * 256 * 1024, 1024, lds); }
    const bool isctx = m0 >= NLAT;
    const int bb = isctx ? ((m0 - NLAT) >> 8) : (m0 >> 12);
    const int key_base = (isctx ? 4096 : (m0 & 4095)) + wm * 128;
    if (tn < 5) {
      const bool isk = (tn == 4);
      const float* nwp = (isk ? p.k_norm_w : p.q_norm_w) + l * 64 + 4 * g4;
      f32x4 nwv[4];
#pragma unroll
      for (int i = 0; i < 4; ++i) nwv[i] = *(const f32x4*)(nwp + i * 16);
      const float* cs = (const float*)(ows(p) + OFF_ROPE);
      const float osc = isk ? 1.f : QSCALE;
      char* buf = lds + 49152 + w * 4096;
      bfu* Kp = (bfu*)(ows(p) + OFF_KP);
#pragma unroll
      for (int ps = 0; ps < 4; ++ps) {
#pragma unroll
        for (int jj = 0; jj < 2; ++jj) {
          const int j = ps * 2 + jj;
          f32x4 v[4];
          float ss = 0.f;
#pragma unroll
          for (int i = 0; i < 4; ++i) { v[i] = acc[i][j]; ss += v[i][0] * v[i][0] + v[i][1] * v[i][1] + v[i][2] * v[i][2] + v[i][3] * v[i][3]; }
          ss += __shfl_xor(ss, 16);
          ss += __shfl_xor(ss, 32);
          const float rstd = rsqrtf(ss * (1.f / 64.f) + EPS);
#pragma unroll
          for (int i = 0; i < 4; ++i)
#pragma unroll
            for (int r = 0; r < 4; ++r) v[i][r] = v[i][r] * rstd * nwv[i][r];
          if (!isctx) {
            const int t = (m0 & 4095) + wm * 128 + j * 16 + lr;
            const float* cr = cs + ((t >> 6) * 16 + 4 * g4) * 2;
            const float* cc = cs + ((t & 63) * 16 + 4 * g4) * 2;
            const f32x4 r0 = *(const f32x4*)cr, r1 = *(const f32x4*)(cr + 4), c0 = *(const f32x4*)cc, c1 = *(const f32x4*)(cc + 4);
            const float rcs[8] = {r0[0], r0[1], r0[2], r0[3], r1[0], r1[1], r1[2], r1[3]};
            const float ccs[8] = {c0[0], c0[1], c0[2], c0[3], c1[0], c1[1], c1[2], c1[3]};
#pragma unroll
            for (int r = 0; r < 4; ++r) {
              float co = rcs[2 * r], si = rcs[2 * r + 1];
              float x1 = v[0][r], x2 = v[1][r];
              v[0][r] = x1 * co - x2 * si; v[1][r] = x2 * co + x1 * si;
              co = ccs[2 * r]; si = ccs[2 * r + 1];
              x1 = v[2][r]; x2 = v[3][r];
              v[2][r] = x1 * co - x2 * si; v[3][r] = x2 * co + x1 * si;
            }
          }
#pragma unroll
          for (int i = 0; i < 4; ++i)
            epi2_put(buf, i, jj, lr, g4, pack2(v[i][0] * osc, v[i][1] * osc), pack2(v[i][2] * osc, v[i][3] * osc));
        }
        if (isk) epi2_flush(buf, lane, Kp + ((size_t)(bb * 2 + wn) * NKEY + key_base + ps * 32) * 64, 64);
        else epi2_flush(buf, lane, P + (size_t)(m0 + wm * 128 + ps * 32) * PS + n0 + wn * 64, PS);
      }
    } else if (tn == 5) {
      char* buf = lds + 49152 + w * 4096;
      bfu* Vt = (bfu*)(ows(p) + OFF_VT);
#pragma unroll
      for (int ps = 0; ps < 4; ++ps) {
#pragma unroll
        for (int i = 0; i < 4; ++i)
#pragma unroll
          for (int jj = 0; jj < 2; ++jj)
#pragma unroll
            for (int r = 0; r < 4; ++r)
              *(bfu*)(buf + (i * 16 + 4 * g4 + r) * 64 + (jj * 16 + lr) * 2) = f2bf(acc[i][ps * 2 + jj][r]);
#pragma unroll
        for (int q = 0; q < 4; ++q) {
          const int chunk = q * 64 + lane, d = chunk >> 2, c = chunk & 3;
          const u32x4 vv = *(const u32x4*)(buf + d * 64 + c * 16);
          *(u32x4*)(Vt + ((size_t)(bb * 2 + wn) * 64 + d) * NKEY + key_base + ps * 32 + c * 8) = vv;
        }
      }
    } else if (tn >= 22 && tn < 30) {
      const int ch0 = ((tn - 22) * 2 + wn) * 32 + 4 * g4;
#pragma unroll
      for (int j = 0; j < 8; ++j) {
        const size_t ro = (size_t)(m0 + wm * 128 + j * 16 + lr) * PS + PC_GLU + ch0;
#pragma unroll
        for (int i = 0; i < 2; ++i) {
          u32x2 o;
          o[0] = pack2(acc[i][j][0] * sigmoidf_(acc[i + 2][j][0]), acc[i][j][1] * sigmoidf_(acc[i + 2][j][1]));
          o[1] = pack2(acc[i][j][2] * sigmoidf_(acc[i + 2][j][2]), acc[i][j][3] * sigmoidf_(acc[i + 2][j][3]));
          *(u32x2*)(P + ro + i * 16) = o;
        }
      }
    } else if (tn < 34) {
      const bool act = (tn >= 6 && tn < 10) || (tn >= 18 && tn < 22) || tn >= 30;
      char* buf = lds + 49152 + w * 4096;
#pragma unroll
      for (int ps = 0; ps < 4; ++ps) {
#pragma unroll
        for (int i = 0; i < 4; ++i)
#pragma unroll
          for (int jj = 0; jj < 2; ++jj)
          {
            f32x4 a = acc[i][ps * 2 + jj];
            if (act) { a[0] = siluf_(a[0]); a[1] = siluf_(a[1]); a[2] = siluf_(a[2]); a[3] = siluf_(a[3]); }
            epi2_put(buf, i, jj, lr, g4, pack2(a[0], a[1]), pack2(a[2], a[3]));
          }
        epi2_flush(buf, lane, P + (size_t)(m0 + wm * 128 + ps * 32) * PS + n0 + wn * 64, PS);
      }
    } else if (wn == 0) {
      const f32x4 dbias = *(const f32x4*)(p.ssd_dt_bias + l * 16 + 4 * g4);
#pragma unroll
      for (int j = 0; j < 8; ++j) {
        const int m = m0 + wm * 128 + j * 16 + lr;
        f32x4 o;
#pragma unroll
        for (int r = 0; r < 4; ++r) {
          const float x = acc[0][j][r] + dbias[r], ex = fexp(x);
          const float sp = (ex < 0.01f) ? ex * (1.f - ex * (0.5f - ex * (1.f / 3.f))) : __builtin_amdgcn_logf(1.f + ex) * 0.6931471805599453f;
          o[r] = (x > 20.f) ? x : sp;
        }
        *(f32x4*)(dtraw + (size_t)m * 16 + 4 * g4) = o;
      }
    }
  }
}

DI void prep_unit(const Params& p, int l, int tile, const float* cs  , const float* qkw  , bool dry = false) {
  bfu* P = (bfu*)(ows(p) + OFF_P);
  bfu* Kp = (bfu*)(ows(p) + OFF_KP);
  bfu* Vt = (bfu*)(ows(p) + OFF_VT);
  float* dt = (float*)(ows(p) + OFF_DT);
  const int tid = otid();
  const int R0 = tile * 64;
  const bool isctx = R0 >= NLAT;
  const int b = isctx ? ((R0 - NLAT) >> 8) : (R0 >> 12);
  const int t0 = isctx ? ((R0 - NLAT) & 255) : (R0 & 4095);
  const int key0 = isctx ? 4096 + t0 : t0;
  for (int it = tid; it < 640; it += 256) {
    const int rr = it / 10, hh = it - rr * 10;
    const int row = R0 + rr;
    bfu* src = P + (size_t)row * PS + (hh < 8 ? hh * 64 : PC_K + (hh - 8) * 64);
    float v[64];
    float ss = 0.f;
#pragma unroll
    for (int i = 0; i < 8; ++i) {
      u32x4 raw = ((const u32x4*)src)[i];
#pragma unroll
      for (int e = 0; e < 4; ++e) { v[i * 8 + 2 * e] = lo_f(raw[e]); v[i * 8 + 2 * e + 1] = hi_f(raw[e]); }
    }
#pragma unroll
    for (int d = 0; d < 64; ++d) ss += v[d] * v[d];
    const float rstd = rsqrtf(ss * (1.f / 64.f) + EPS);
    const float* nw = qkw + (hh < 8 ? 0 : 64);
#pragma unroll
    for (int d = 0; d < 64; ++d) v[d] = v[d] * rstd * nw[d];
    if (!isctx) {
      const int t = t0 + rr;
      const int rp = t >> 6, cp = t & 63;
#pragma unroll
      for (int f = 0; f < 16; ++f) {
        float c = cs[(rp * 16 + f) * 2], s = cs[(rp * 16 + f) * 2 + 1];
        float x1 = v[f], x2 = v[16 + f];
        v[f] = x1 * c - x2 * s; v[16 + f] = x2 * c + x1 * s;
        c = cs[(cp * 16 + f) * 2]; s = cs[(cp * 16 + f) * 2 + 1];
        x1 = v[32 + f]; x2 = v[48 + f];
        v[32 + f] = x1 * c - x2 * s; v[48 + f] = x2 * c + x1 * s;
      }
    }
    bfu* dst;
    float sc = 1.f;
    if (hh < 8) { dst = src; sc = QSCALE; }
    else dst = Kp + ((size_t)(b * 2 + (hh - 8)) * NKEY + key0 + rr) * 64;
#pragma unroll
    for (int i = 0; i < 8; ++i) {
      u32x4 o;
#pragma unroll
      for (int e = 0; e < 4; ++e) o[e] = pack2(v[i * 8 + 2 * e] * sc, v[i * 8 + 2 * e + 1] * sc);
      if (!dry) ((u32x4*)dst)[i] = o;
    }
  }
  {
    const int c = tid & 127, half = tid >> 7, kv = c >> 6, d = c & 63;
    u32x4 o[4];
#pragma unroll
    for (int j = 0; j < 16; ++j) {
      const int row = R0 + half * 32 + 2 * j;
      unsigned a = P[(size_t)row * PS + PC_V + c], b2 = P[(size_t)(row + 1) * PS + PC_V + c];
      o[j >> 2][j & 3] = a | (b2 << 16);
    }
    u32x4* dst = (u32x4*)(Vt + ((size_t)(b * 2 + kv) * 64 + d) * NKEY + key0 + half * 32);
#pragma unroll
    for (int j = 0; j < 4; ++j) if (!dry) dst[j] = o[j];
  }
  {
    const int idx = tid * 4, row = R0 + (idx >> 4), j = idx & 15;
    f32x4 r = *(f32x4*)(dt + (size_t)row * 16 + j);
    const float* bias = p.ssd_dt_bias + l * 16 + j;
#pragma unroll
    for (int e = 0; e < 4; ++e) { float x = r[e] + bias[e]; r[e] = (x > 20.f) ? x : log1pf(expf(x)); }
    if (!dry) *(f32x4*)(dt + (size_t)row * 16 + j) = r;
  }
}

DI void conf_unit(const Params& p, int l, int tile32, char* lds, bool dry = false) {
  bfu* P = (bfu*)(ows(p) + OFF_P);
  const int tid = otid(), lane = tid & 63, w = tid >> 6;
  const int R0 = tile32 * 32;
  const bool isctx = R0 >= NLAT;
  const int S0 = isctx ? NLAT + (((R0 - NLAT) >> 8) << 8) : ((R0 >> 12) << 12);
  const int Ls = isctx ? 256 : 4096;
  const int t0 = R0 - S0;
  bfu* vt = (bfu*)lds;
  float* red = (float*)(lds + 63488);
  for (int it = tid; it < 62 * 64; it += 256) {
    const int rr = it >> 6, ck = it & 63;
    const int t = t0 - 15 + rr;
    u32x4 o = u32x4{0u, 0u, 0u, 0u};
    if (t >= 0 && t < Ls) {
      const bfu* rp = P + (size_t)(S0 + t) * PS + PC_GLU + ck * 8;
      o = *(const u32x4*)rp;
    }
    *(u32x4*)(vt + rr * 512 + ck * 8) = o;
  }
  __syncthreads();
  const int c0 = 2 * tid;
  float w0[31], w1[31];
#pragma unroll
  for (int k = 0; k < 31; ++k) {
    const float* wp = p.cm_conv_w + ((size_t)l * 31 + k) * 512 + c0;
    w0[k] = wp[0]; w1[k] = wp[1];
  }
  const float bias0 = p.cm_conv_b[l * 512 + c0], bias1 = p.cm_conv_b[l * 512 + c0 + 1];
  const float lw0 = p.cm_ln_w[l * 512 + c0], lw1 = p.cm_ln_w[l * 512 + c0 + 1];
  const float lb0 = p.cm_ln_b[l * 512 + c0], lb1 = p.cm_ln_b[l * 512 + c0 + 1];
#pragma unroll 1
  for (int half = 0; half < 2; ++half) {
    float o0[16], o1[16];
#pragma unroll
    for (int o = 0; o < 16; ++o) { o0[o] = bias0; o1[o] = bias1; }
    const bfu* vb = vt + (half * 16) * 512 + c0;
#pragma unroll
    for (int r = 0; r < 46; ++r) {
      const unsigned pr = *(const unsigned*)(vb + r * 512);
      const float a = lo_f(pr), b2 = hi_f(pr);
#pragma unroll
      for (int o = 0; o < 16; ++o) {
        const int k = r - o;
        if (k >= 0 && k <= 30) { o0[o] += w0[k] * a; o1[o] += w1[k] * b2; }
      }
    }
#pragma unroll
    for (int o = 0; o < 16; ++o) {
      float s1 = wave_sum(o0[o] + o1[o]);
      float s2 = wave_sum(o0[o] * o0[o] + o1[o] * o1[o]);
      if (lane == 0) { red[(w * 16 + o) * 2] = s1; red[(w * 16 + o) * 2 + 1] = s2; }
    }
    __syncthreads();
#pragma unroll
    for (int o = 0; o < 16; ++o) {
      float s1 = red[o * 2] + red[(16 + o) * 2] + red[(32 + o) * 2] + red[(48 + o) * 2];
      float s2 = red[o * 2 + 1] + red[(16 + o) * 2 + 1] + red[(32 + o) * 2 + 1] + red[(48 + o) * 2 + 1];
      const float mu = s1 * (1.f / 512.f);
      const float var = fmaxf(s2 * (1.f / 512.f) - mu * mu, 0.f);
      const float rstd = rsqrtf(var + EPS);
      unsigned* gp = (unsigned*)(P + (size_t)(R0 + half * 16 + o) * PS + PC_GCV + c0);
      const unsigned gv = *gp;
      float y0 = siluf_((o0[o] - mu) * rstd * lw0 + lb0) * lo_f(gv);
      float y1 = siluf_((o1[o] - mu) * rstd * lw1 + lb1) * hi_f(gv);
      if (!dry) *gp = pack2(y0, y1);
    }
    __syncthreads();
  }
}

DI void phaseC1(const Params& p, int l, char* lds, bool dry = false) {
  const int nconf = (l == 0) ? NROWS / 32 : NLAT / 32;
  for (int u = blockIdx.x; u < nconf; u += gridDim.x) conf_unit(p, l, (u & 7) * (nconf >> 3) + (u >> 3), lds, dry);
}

DI void attn_unit(const Params& p, int l, int u, char* lds, bool dry = false) {
  bfu* P = (bfu*)(ows(p) + OFF_P);
  const bfu* Kp = (const bfu*)(ows(p) + OFF_KP);
  const bfu* Vt = (const bfu*)(ows(p) + OFF_VT);
  const int tid = otid(), lane = tid & 63, w = tid >> 6, lr = lane & 15, g4 = lane >> 4;
  int b, kv, Rq0, key_lo;
  if (u < 1024) { const int pair = (u & 7) * 2 + (u >> 9); b = pair >> 1; kv = pair & 1; Rq0 = b * 4096 + ((u >> 3) & 63) * 64; key_lo = 0; }
  else { const int v = u - 1024; b = v >> 3; kv = (v >> 2) & 1; Rq0 = NLAT + b * 256 + (v & 3) * 64; key_lo = 4096; }
  const int nt = (NKEY - key_lo) >> 6;
  const int head = kv * 4 + w;
  bf16x8 qf[4][2];
#pragma unroll
  for (int qt = 0; qt < 4; ++qt)
#pragma unroll
    for (int s = 0; s < 2; ++s)
      qf[qt][s] = *(const bf16x8*)(P + (size_t)(Rq0 + qt * 16 + lr) * PS + head * 64 + s * 32 + g4 * 8);
  const bfu* Kb = Kp + (size_t)(b * 2 + kv) * NKEY * 64;
  const bfu* Vb = Vt + (size_t)(b * 2 + kv) * 64 * NKEY;
  constexpr int STAGE = 8192 + 10240;
  const int lrow = tid >> 2, lc = tid & 3;
  const int lcs = (lc ^ swz(lrow)) * 16;
  u32x4 kr[2], vr[2];
  auto gload = [&](int key0) {
    kr[0] = *(const u32x4*)(Kb + (size_t)(key0 + lrow) * 64 + lc * 8);
    kr[1] = *(const u32x4*)(Kb + (size_t)(key0 + lrow) * 64 + 32 + lc * 8);
    vr[0] = *(const u32x4*)(Vb + (size_t)lrow * NKEY + key0 + lc * 8);
    vr[1] = *(const u32x4*)(Vb + (size_t)lrow * NKEY + key0 + 32 + lc * 8);
  };
  auto lstore = [&](int st) {
    char* sk = lds + st * STAGE;
    char* sv = sk + 8192;
    *(u32x4*)(sk + lrow * 64 + lcs) = kr[0];
    *(u32x4*)(sk + 4096 + lrow * 64 + lcs) = kr[1];
    *(u32x4*)(sv + lrow * 80 + lc * 16) = vr[0];
    *(u32x4*)(sv + 5120 + lrow * 80 + lc * 16) = vr[1];
  };
  float nshift;
  {
    float wq = fabsf(p.q_norm_w[l * 64 + lane]), wk = fabsf(p.k_norm_w[l * 64 + lane]);
#pragma unroll
    for (int o = 32; o >= 1; o >>= 1) { wq = fmaxf(wq, __shfl_xor(wq, o)); wk = fmaxf(wk, __shfl_xor(wk, o)); }
    nshift = -(64.f * QSCALE) * wq * wk;
  }
  f32x4 O[4][4];
  float lrun[4];
#pragma unroll
  for (int qt = 0; qt < 4; ++qt) {
    lrun[qt] = 0.f;
#pragma unroll
    for (int d = 0; d < 4; ++d) O[qt][d] = f32x4{0.f, 0.f, 0.f, 0.f};
  }
  const int fsw = (g4 ^ swz(lr)) * 16;
  gload(key_lo);
  lstore(0);
  __syncthreads();
  for (int t = 0; t < nt; ++t) {
    const int cur = t & 1;
    if (t + 1 < nt) gload(key_lo + (t + 1) * 64);
    const char* sk = lds + cur * STAGE;
    const char* sv = sk + 8192;
#pragma unroll
    for (int kb = 0; kb < 2; ++kb) {
      bf16x8 kf[2][2], vf[4];
#pragma unroll
      for (int t2 = 0; t2 < 2; ++t2)
#pragma unroll
        for (int s = 0; s < 2; ++s)
          kf[t2][s] = *(const bf16x8*)(sk + s * 4096 + (kb * 32 + t2 * 16 + lr) * 64 + fsw);
#pragma unroll
      for (int d = 0; d < 4; ++d) {
        const char* vp = sv + kb * 5120 + (d * 16 + lr) * 80 + g4 * 8;
        u32x2 lo = *(const u32x2*)vp, hi = *(const u32x2*)(vp + 32);
        u32x4 vv; vv[0] = lo[0]; vv[1] = lo[1]; vv[2] = hi[0]; vv[3] = hi[1];
        vf[d] = as_bf8(vv);
      }
#pragma unroll
      for (int qt = 0; qt < 4; ++qt) {
        f32x4 s0 = f32x4{nshift, nshift, nshift, nshift}, s1 = s0;
        s0 = mfma16(kf[0][0], qf[qt][0], s0); s0 = mfma16(kf[0][1], qf[qt][1], s0);
        s1 = mfma16(kf[1][0], qf[qt][0], s1); s1 = mfma16(kf[1][1], qf[qt][1], s1);
        const float p0 = fexp2(s0[0]), p1 = fexp2(s0[1]), p2 = fexp2(s0[2]), p3 = fexp2(s0[3]);
        const float p4 = fexp2(s1[0]), p5 = fexp2(s1[1]), p6 = fexp2(s1[2]), p7 = fexp2(s1[3]);
        lrun[qt] += ((p0 + p1) + (p2 + p3)) + ((p4 + p5) + (p6 + p7));
        u32x4 pp; pp[0] = pack2(p0, p1); pp[1] = pack2(p2, p3); pp[2] = pack2(p4, p5); pp[3] = pack2(p6, p7);
        const bf16x8 pb = as_bf8(pp);
#pragma unroll
        for (int d = 0; d < 4; ++d) {
          O[qt][d] = mfma16(vf[d], pb, O[qt][d]);
        }
      }
    }
    if (t + 1 < nt) lstore(cur ^ 1);
    __syncthreads();
  }
#pragma unroll
  for (int qt = 0; qt < 4; ++qt) {
    float lsum = lrun[qt];
    lsum += __shfl_xor(lsum, 16);
    lsum += __shfl_xor(lsum, 32);
    const float inv = 1.f / lsum;
    const size_t rowoff = (size_t)(Rq0 + qt * 16 + lr) * PS;
#pragma unroll
    for (int d = 0; d < 4; ++d) {
      const int col = head * 64 + d * 16 + 4 * g4;
      const u32x2 gr = *(const u32x2*)(P + rowoff + PC_GA + col);
      u32x2 o;
      o[0] = pack2(O[qt][d][0] * inv * lo_f(gr[0]), O[qt][d][1] * inv * hi_f(gr[0]));
      o[1] = pack2(O[qt][d][2] * inv * lo_f(gr[1]), O[qt][d][3] * inv * hi_f(gr[1]));
      if (!dry) *(u32x2*)(P + rowoff + PC_Q + col) = o;
    }
  }
}

DI void ssdconv_unit(const Params& p, int l, int u, char* lds) {
  bfu* P = (bfu*)(ows(p) + OFF_P);
  bfu* BT = (bfu*)(ows(p) + OFF_BT);
  const int tid = otid();
  const int tile = u >> 2, cb = u & 3;
  const int R0 = tile * 64;
  const bool isctx = R0 >= NLAT;
  const int S0 = isctx ? NLAT + (((R0 - NLAT) >> 8) << 8) : ((R0 >> 12) << 12);
  const int Ls = isctx ? 256 : 4096;
  const int t0 = R0 - S0;
  bfu* xt = (bfu*)lds;
  for (int it = tid; it < 68 * 32; it += 256) {
    const int rr = it >> 5, ck = it & 31;
    const int t = t0 - 2 + rr;
    u32x4 v = u32x4{0u, 0u, 0u, 0u};
    if (t >= 0 && t < Ls) v = *(const u32x4*)(P + (size_t)(S0 + t) * PS + PC_XBC + cb * 256 + ck * 8);
    *(u32x4*)(xt + rr * 256 + ck * 8) = v;
  }
  __syncthreads();
  const int ch = cb * 256 + tid;
  float wk[5];
#pragma unroll
  for (int k = 0; k < 5; ++k) wk[k] = p.ssd_conv_w[((size_t)l * 5 + k) * 1024 + ch];
  const float bias = p.ssd_conv_b[l * 1024 + ch];
  const int Rc = R0 & ~127;
  for (int grp = 0; grp < 8; ++grp) {
    float o[8];
#pragma unroll
    for (int e = 0; e < 8; ++e) {
      const int tt = grp * 8 + e;
      float a = bias;
#pragma unroll
      for (int k = 0; k < 5; ++k) a += wk[k] * bf2f(xt[(tt + k) * 256 + tid]);
      o[e] = siluf_(a);
    }
    u32x4 pk; pk[0] = pack2(o[0], o[1]); pk[1] = pack2(o[2], o[3]); pk[2] = pack2(o[4], o[5]); pk[3] = pack2(o[6], o[7]);
    if (cb < 2) {
      const int tok = (R0 & 127) + grp * 8;
      *(u32x4*)(P + (size_t)(Rc + (ch >> 2)) * PS + PC_GLU + (ch & 3) * 128 + tok) = pk;
    } else {
#pragma unroll
      for (int e = 0; e < 8; ++e) P[(size_t)(R0 + grp * 8 + e) * PS + PC_GLU + ch] = f2bf(o[e]);
      if (cb == 2) *(u32x4*)(BT + (size_t)(ch - 512) * NROWS + R0 + grp * 8) = pk;
    }
  }
  __syncthreads();
}

DI void phaseC2(const Params& p, int l, char* lds, bool dry = false) {
  const int nattn = (l == 0) ? 1088 : 1024;
  const int nconv = (NROWS / 64) * 4;
  for (int u = blockIdx.x; u < nattn + nconv; u += gridDim.x) {
    if (u < nattn) attn_unit(p, l, u, lds, dry);
    else if (!dry) ssdconv_unit(p, l, u - nattn, lds);
  }
}

DI void chunk_info(int ci, int& b, int& slot) {
  if (ci < 256) { b = ci >> 5; slot = 2 + (ci & 31); } else { b = (ci - 256) >> 1; slot = (ci - 256) & 1; }
}
DI size_t xT_off(int R0, int ch, int tok) { return (size_t)(R0 + (ch >> 2)) * PS + PC_GLU + (ch & 3) * 128 + tok; }

DI void chunk_cumsum(const float* dt, int R0, int col, float A, int lane, float& d0, float& d1, float& inc0, float& inc1,
                     float& exc0, float& exc1, float& total) {
  d0 = dt[(size_t)(R0 + 2 * lane) * 16 + col];
  d1 = dt[(size_t)(R0 + 2 * lane + 1) * 16 + col];
  const float a0 = d0 * A, a1 = d1 * A;
  const float local = a0 + a1;
  float inc = local;
#pragma unroll
  for (int o = 1; o < 64; o <<= 1) { float t = __shfl_up(inc, o); if (lane >= o) inc += t; }
  const float excl = inc - local;
  exc0 = excl; exc1 = excl + a0; inc0 = excl + a0; inc1 = inc;
  total = __shfl(inc, 63);
}

DI void sloc_unit(const Params& p, int l, int u, char* lds) {
  const bfu* P = (const bfu*)(ows(p) + OFF_P);
  const bfu* BT = (const bfu*)(ows(p) + OFF_BT);
  const float* dt = (const float*)(ows(p) + OFF_DT);
  bfu* St = (bfu*)(ows(p) + OFF_ST);
  float* dec = (float*)(ows(p) + OFF_DEC);
  const int tid = otid(), lane = tid & 63, w = tid >> 6, lr = lane & 15, g4 = lane >> 4;
  const int h = (u >> 3) & 7, ci = (u & 7) | ((u >> 6) << 3), grp = h >> 2;
  const int R0 = ci * 128;
  int b, slot; chunk_info(ci, b, slot);
  float* wdt = (float*)lds;
  if (w < 2) {
    const int dir = w;
    const float A = -expf(p.ssd_A_log[l * 16 + dir * 8 + h]);
    float d0, d1, inc0, inc1, exc0, exc1, total;
    chunk_cumsum(dt, R0, dir * 8 + h, A, lane, d0, d1, inc0, inc1, exc0, exc1, total);
    float w0, w1;
    if (dir == 0) { w0 = fexp(total - inc0); w1 = fexp(total - inc1); }
    else { w0 = fexp(exc0); w1 = fexp(exc1); }
    wdt[dir * 128 + 2 * lane] = d0 * w0;
    wdt[dir * 128 + 2 * lane + 1] = d1 * w1;
    if (lane == 0) dec[((size_t)(b * 2 + dir) * NSLOT + slot) * 8 + h] = fexp(total);
  }
  {
    u32x4 xr[4];
#pragma unroll
    for (int q = 0; q < 4; ++q) {
      const int f = w * 4 + q, ks = f >> 2, pt = f & 3;
      xr[q] = *(const u32x4*)(P + xT_off(R0, h * 64 + pt * 16 + lr, ks * 32 + g4 * 8));
    }
#pragma unroll
    for (int q = 0; q < 4; ++q) *(u32x4*)(lds + 4096 + (w * 4 + q) * 1024 + lane * 16) = xr[q];
  }
  __syncthreads();
  bf16x8 bt[2][4];
#pragma unroll
  for (int i = 0; i < 2; ++i)
#pragma unroll
    for (int ks = 0; ks < 4; ++ks)
      bt[i][ks] = *(const bf16x8*)(BT + (size_t)(grp * 128 + w * 32 + i * 16 + lr) * NROWS + R0 + ks * 32 + g4 * 8);
  f32x4 af[2][4], ab[2][4];
#pragma unroll
  for (int i = 0; i < 2; ++i)
#pragma unroll
    for (int pt = 0; pt < 4; ++pt) { af[i][pt] = f32x4{0.f, 0.f, 0.f, 0.f}; ab[i][pt] = f32x4{0.f, 0.f, 0.f, 0.f}; }
#pragma unroll
  for (int ks = 0; ks < 4; ++ks) {
    const int tok = ks * 32 + g4 * 8;
    const f32x4 wf0 = *(const f32x4*)(wdt + tok), wf1 = *(const f32x4*)(wdt + tok + 4);
    const f32x4 wb0 = *(const f32x4*)(wdt + 128 + tok), wb1 = *(const f32x4*)(wdt + 128 + tok + 4);
#pragma unroll
    for (int pt = 0; pt < 4; ++pt) {
      const u32x4 raw = *(const u32x4*)(lds + 4096 + (ks * 4 + pt) * 1024 + lane * 16);
      u32x4 xf, xb;
      xf[0] = pack2(lo_f(raw[0]) * wf0[0], hi_f(raw[0]) * wf0[1]); xf[1] = pack2(lo_f(raw[1]) * wf0[2], hi_f(raw[1]) * wf0[3]);
      xf[2] = pack2(lo_f(raw[2]) * wf1[0], hi_f(raw[2]) * wf1[1]); xf[3] = pack2(lo_f(raw[3]) * wf1[2], hi_f(raw[3]) * wf1[3]);
      xb[0] = pack2(lo_f(raw[0]) * wb0[0], hi_f(raw[0]) * wb0[1]); xb[1] = pack2(lo_f(raw[1]) * wb0[2], hi_f(raw[1]) * wb0[3]);
      xb[2] = pack2(lo_f(raw[2]) * wb1[0], hi_f(raw[2]) * wb1[1]); xb[3] = pack2(lo_f(raw[3]) * wb1[2], hi_f(raw[3]) * wb1[3]);
#pragma unroll
      for (int i = 0; i < 2; ++i) {
        af[i][pt] = mfma16(bt[i][ks], as_bf8(xf), af[i][pt]);
        ab[i][pt] = mfma16(bt[i][ks], as_bf8(xb), ab[i][pt]);
      }
    }
  }
#pragma unroll
  for (int dir = 0; dir < 2; ++dir) {
    bfu* Sb = St + (((size_t)(b * 2 + dir) * NSLOT + slot) * 8 + h) * 8192;
#pragma unroll
    for (int i = 0; i < 2; ++i)
#pragma unroll
      for (int pt = 0; pt < 4; ++pt) {
        const f32x4 a = dir == 0 ? af[i][pt] : ab[i][pt];
        const int n = w * 32 + i * 16 + 4 * g4, pc = pt * 16 + lr;
        u32x2 o; o[0] = pack2(a[0], a[1]); o[1] = pack2(a[2], a[3]);
        *(u32x2*)(Sb + pc * 128 + n) = o;
      }
  }
  __syncthreads();
}

DI void phaseD2(const Params& p) {
  bfu* St = (bfu*)(ows(p) + OFF_ST);
  const float* dec = (const float*)(ows(p) + OFF_DEC);
  for (int gt = blockIdx.x * 256 + otid(); gt < 8 * 2 * 8 * 1024; gt += gridDim.x * 256) {
    const int e8 = gt & 1023, h = (gt >> 10) & 7, dir = (gt >> 13) & 1, b = gt >> 14;
    bfu* base = St + (size_t)(b * 2 + dir) * NSLOT * 65536 + h * 8192 + e8 * 8;
    const float* db = dec + (size_t)(b * 2 + dir) * NSLOT * 8 + h;
    float carry[8];
#pragma unroll
    for (int e = 0; e < 8; ++e) carry[e] = 0.f;
#pragma unroll 1
    for (int hb = 0; hb < 2; ++hb) {
      u32x4 raws[17];
      float dcys[17];
#pragma unroll
      for (int q = 0; q < 17; ++q) {
        const int step = hb * 17 + q;
        const int slot = (dir == 0) ? step : (step < 2 ? 1 - step : 35 - step);
        raws[q] = *(const u32x4*)(base + (size_t)slot * 65536);
        dcys[q] = db[slot * 8];
      }
#pragma unroll
      for (int q = 0; q < 17; ++q) {
        const int step = hb * 17 + q;
        const int slot = (dir == 0) ? step : (step < 2 ? 1 - step : 35 - step);
        u32x4 o;
#pragma unroll
        for (int e = 0; e < 4; ++e) o[e] = pack2(carry[2 * e], carry[2 * e + 1]);
        *(u32x4*)(base + (size_t)slot * 65536) = o;
#pragma unroll
        for (int e = 0; e < 4; ++e) {
          carry[2 * e] = carry[2 * e] * dcys[q] + lo_f(raws[q][e]);
          carry[2 * e + 1] = carry[2 * e + 1] * dcys[q] + hi_f(raws[q][e]);
        }
      }
    }
  }
}

DI void ssdy_unit(const Params& p, int l, int u, char* lds, bool dry = false) {
  bfu* P = (bfu*)(ows(p) + OFF_P);
  const float* dt = (const float*)(ows(p) + OFF_DT);
  const bfu* St = (const bfu*)(ows(p) + OFF_ST);
  float* ssq = (float*)(ows(p) + OFF_SS);
  const int tid = otid(), lane = tid & 63, w = tid >> 6, lr = lane & 15, g4 = lane >> 4;
  const int h = (u >> 3) & 7, ci = (u & 7) | ((u >> 6) << 3), grp = h >> 2;
  const int R0 = ci * 128;
  int b, slot; chunk_info(ci, b, slot);
  float* acf = (float*)(lds + 61440);
  float* rcb = acf + 128;
  float* dtf = acf + 256;
  float* dtb = acf + 384;
  if (w < 2) {
    const int dir = w;
    const float A = -expf(p.ssd_A_log[l * 16 + dir * 8 + h]);
    float d0, d1, inc0, inc1, exc0, exc1, total;
    chunk_cumsum(dt, R0, dir * 8 + h, A, lane, d0, d1, inc0, inc1, exc0, exc1, total);
    if (dir == 0) { acf[2 * lane] = inc0; acf[2 * lane + 1] = inc1; dtf[2 * lane] = d0; dtf[2 * lane + 1] = d1; }
    else { rcb[2 * lane] = total - exc0; rcb[2 * lane + 1] = total - exc1; dtb[2 * lane] = d0; dtb[2 * lane + 1] = d1; }
  }
  {
    u32x4 sreg[8];
#pragma unroll
    for (int q = 0; q < 8; ++q) {
      const int f = w * 8 + q, dir = f >> 4, pt = (f >> 2) & 3, ks = f & 3;
      const bfu* Sb = St + (((size_t)(b * 2 + dir) * NSLOT + slot) * 8 + h) * 8192;
      sreg[q] = *(const u32x4*)(Sb + (pt * 16 + lr) * 128 + ks * 32 + g4 * 8);
    }
#pragma unroll
    for (int q = 0; q < 8; ++q) *(u32x4*)(lds + (w * 8 + q) * 1024 + lane * 16) = sreg[q];
  }
  __syncthreads();
  const int l0 = w * 32;
  bf16x8 cf[2][4];
#pragma unroll
  for (int lt = 0; lt < 2; ++lt)
#pragma unroll
    for (int ks = 0; ks < 4; ++ks)
      cf[lt][ks] = *(const bf16x8*)(P + (size_t)(R0 + l0 + lt * 16 + lr) * PS + PC_GLU + 768 + grp * 128 + ks * 32 + g4 * 8);
  float al[2], rl[2];
#pragma unroll
  for (int lt = 0; lt < 2; ++lt) { al[lt] = acf[l0 + lt * 16 + lr]; rl[lt] = rcb[l0 + lt * 16 + lr]; }
  f32x4 yacc[2][4];
#pragma unroll
  for (int dir = 0; dir < 2; ++dir) {
    f32x4 tmp[2][4];
#pragma unroll
    for (int lt = 0; lt < 2; ++lt)
#pragma unroll
      for (int pt = 0; pt < 4; ++pt) tmp[lt][pt] = f32x4{0.f, 0.f, 0.f, 0.f};
#pragma unroll
    for (int pt = 0; pt < 4; ++pt)
#pragma unroll
      for (int ks = 0; ks < 4; ++ks) {
        const bf16x8 sf = *(const bf16x8*)(lds + (dir * 16 + pt * 4 + ks) * 1024 + lane * 16);
#pragma unroll
        for (int lt = 0; lt < 2; ++lt) tmp[lt][pt] = mfma16(sf, cf[lt][ks], tmp[lt][pt]);
      }
#pragma unroll
    for (int lt = 0; lt < 2; ++lt) {
      const float e = fexp(dir == 0 ? al[lt] : rl[lt]);
#pragma unroll
      for (int pt = 0; pt < 4; ++pt) {
        if (dir == 0) yacc[lt][pt] = tmp[lt][pt] * e;
        else yacc[lt][pt] += tmp[lt][pt] * e;
      }
    }
  }
  __syncthreads();
  {
    u32x4 breg[12];
#pragma unroll
    for (int j = 0; j < 8; ++j) {
      const int st = j >> 2, ks = j & 3;
      breg[j] = *(const u32x4*)(P + (size_t)(R0 + w * 32 + st * 16 + lr) * PS + PC_GLU + 512 + grp * 128 + ks * 32 + g4 * 8);
    }
#pragma unroll
    for (int pt = 0; pt < 4; ++pt) {
      const int ch = h * 64 + pt * 16 + lr;
      const bfu* xp = P + xT_off(R0, ch, w * 32 + 4 * g4);
      const u32x2 lo = *(const u32x2*)xp, hi = *(const u32x2*)(xp + 16);
      breg[8 + pt][0] = lo[0]; breg[8 + pt][1] = lo[1]; breg[8 + pt][2] = hi[0]; breg[8 + pt][3] = hi[1];
    }
#pragma unroll
    for (int j = 0; j < 12; ++j) *(u32x4*)(lds + (w * 12 + j) * 1024 + lane * 16) = breg[j];
  }
  __syncthreads();
#pragma unroll 1
  for (int sb = 0; sb < 4; ++sb) {
    const bool dof = sb <= w, dob = sb >= w;
    bf16x8 bfr[2][4];
#pragma unroll
    for (int st = 0; st < 2; ++st)
#pragma unroll
      for (int ks = 0; ks < 4; ++ks)
        bfr[st][ks] = *(const bf16x8*)(lds + (sb * 12 + st * 4 + ks) * 1024 + lane * 16);
    f32x4 acs[2], rcs[2], dfs[2], dbs[2];
#pragma unroll
    for (int st = 0; st < 2; ++st) {
      const int s0 = sb * 32 + st * 16 + 4 * g4;
      acs[st] = *(const f32x4*)(acf + s0); rcs[st] = *(const f32x4*)(rcb + s0);
      dfs[st] = *(const f32x4*)(dtf + s0); dbs[st] = *(const f32x4*)(dtb + s0);
    }
    bf16x8 xa[4];
#pragma unroll
    for (int pt = 0; pt < 4; ++pt) xa[pt] = *(const bf16x8*)(lds + (sb * 12 + 8 + pt) * 1024 + lane * 16);
#pragma unroll
    for (int lt = 0; lt < 2; ++lt) {
      f32x4 cb0 = f32x4{0.f, 0.f, 0.f, 0.f}, cb1 = f32x4{0.f, 0.f, 0.f, 0.f};
#pragma unroll
      for (int ks = 0; ks < 4; ++ks) { cb0 = mfma16(bfr[0][ks], cf[lt][ks], cb0); cb1 = mfma16(bfr[1][ks], cf[lt][ks], cb1); }
      const int lpos = l0 + lt * 16 + lr;
      const int sA = sb * 32 + 4 * g4, sB = sA + 16;
      if (dof) {
        float m[8];
#pragma unroll
        for (int r = 0; r < 4; ++r) {
          m[r] = (sA + r <= lpos) ? cb0[r] * fexp(al[lt] - acs[0][r]) * dfs[0][r] : 0.f;
          m[4 + r] = (sB + r <= lpos) ? cb1[r] * fexp(al[lt] - acs[1][r]) * dfs[1][r] : 0.f;
        }
        u32x4 pp; pp[0] = pack2(m[0], m[1]); pp[1] = pack2(m[2], m[3]); pp[2] = pack2(m[4], m[5]); pp[3] = pack2(m[6], m[7]);
#pragma unroll
        for (int pt = 0; pt < 4; ++pt) yacc[lt][pt] = mfma16(xa[pt], as_bf8(pp), yacc[lt][pt]);
      }
      if (dob) {
        float m[8];
#pragma unroll
        for (int r = 0; r < 4; ++r) {
          m[r] = (sA + r >= lpos) ? cb0[r] * fexp(rl[lt] - rcs[0][r]) * dbs[0][r] : 0.f;
          m[4 + r] = (sB + r >= lpos) ? cb1[r] * fexp(rl[lt] - rcs[1][r]) * dbs[1][r] : 0.f;
        }
        u32x4 pp; pp[0] = pack2(m[0], m[1]); pp[1] = pack2(m[2], m[3]); pp[2] = pack2(m[4], m[5]); pp[3] = pack2(m[6], m[7]);
#pragma unroll
        for (int pt = 0; pt < 4; ++pt) yacc[lt][pt] = mfma16(xa[pt], as_bf8(pp), yacc[lt][pt]);
      }
    }
  }
  const float Dh = p.ssd_D[l * 8 + h];
#pragma unroll
  for (int lt = 0; lt < 2; ++lt) {
    const int lpos = l0 + lt * 16 + lr;
    const size_t rowoff = (size_t)(R0 + lpos) * PS;
    float sq = 0.f;
#pragma unroll
    for (int pt = 0; pt < 4; ++pt) {
      const int p0 = pt * 16 + 4 * g4;
      bfu* zp = P + rowoff + PC_Z + h * 64 + p0;
      const u32x2 zr = *(const u32x2*)zp;
      const int tt = lpos & 31;
      const bfu* xl = (const bfu*)(lds + ((lpos >> 5) * 12 + 8 + pt) * 1024 + (((tt & 15) >> 2) * 16 + 4 * g4) * 16) + (tt & 3) + ((tt >> 4) << 2);
      float yv[4];
#pragma unroll
      for (int r = 0; r < 4; ++r) {
        const float xv = bf2f(xl[r * 8]);
        const float zv = (r & 1) ? hi_f(zr[r >> 1]) : lo_f(zr[r >> 1]);
        yv[r] = (yacc[lt][pt][r] + Dh * xv) * zv;
        sq += yv[r] * yv[r];
      }
      u32x2 o; o[0] = pack2(yv[0], yv[1]); o[1] = pack2(yv[2], yv[3]);
      if (!dry) *(u32x2*)zp = o;
    }
    sq += __shfl_xor(sq, 16);
    sq += __shfl_xor(sq, 32);
    if (g4 == 0 && !dry) ssq[(size_t)(R0 + lpos) * 8 + h] = sq;
  }
  __syncthreads();
}

DI void phaseG(const Params& p, int l, char* lds) {
  const bfu* Wg = (const bfu*)(ows(p) + OFF_WG) + (size_t)l * 3072 * 1024;
  const bfu* Wbr = (const bfu*)(ows(p) + OFF_WBR) + (size_t)l * 3 * 1024 * 512;
  const bfu* H = (const bfu*)(ows(p) + OFF_H);
  const bfu* P = (const bfu*)(ows(p) + OFF_P);
  const float* ssq = (const float*)(ows(p) + OFF_SS);
  bfu* Y = (bfu*)(ows(p) + OFF_ST);
  const int lane = otid() & 63, w = otid() >> 6, lr = lane & 15, g4 = lane >> 4, wn = w >> 1, wm = w & 1;
  const int nrows = (l == 0) ? NROWS : NLAT;
  const int MT = nrows / 128, MX = MT / 8;
  const int total = MT * 8;
  auto decode = [&](int u, int& tn, int& tm) {
    const int xcd = u & 7, j = u >> 3;
    tn = j & 7; tm = xcd * MX + (j >> 3);
  };
  if ((int)blockIdx.x < total) { int tn, tm; decode(blockIdx.x, tn, tm); gemm_prefetch(Wg + (size_t)(tn * 128) * 1024, 1024, H + (size_t)tm * 128 * 1024, 1024, lds); }
  for (int u = blockIdx.x; u < total; u += gridDim.x) {
    int tn, tm; decode(u, tn, tm);
    const int n0 = tn * 128, m0 = tm * 128;
    u32x2 y[4][4];
#pragma unroll
    for (int i = 0; i < 4; ++i)
#pragma unroll
      for (int j2 = 0; j2 < 4; ++j2) y[i][j2] = u32x2{0u, 0u};
#pragma unroll 1
    for (int br = 0; br < 3; ++br) {
      u32x2 gp[4][4];
      {
        f32x4 ga[4][4];
#pragma unroll
        for (int i = 0; i < 4; ++i)
#pragma unroll
          for (int j2 = 0; j2 < 4; ++j2) ga[i][j2] = f32x4{0.f, 0.f, 0.f, 0.f};
        gemm_core<4, false, true>(Wg + (size_t)(br * 1024 + n0) * 1024, 1024, H + (size_t)m0 * 1024, 1024, 1024, ga, lds);
        {
          const int ucol0 = (br == 0) ? PC_Q : (br == 1 ? PC_Z : PC_GCV);
          gemm_prefetch(Wbr + (size_t)(br * 1024 + n0) * 512, 512, P + (size_t)m0 * PS + ucol0, PS, lds);
        }
#pragma unroll
        for (int i = 0; i < 4; ++i) {
          const f32x4 bg = *(const f32x4*)(p.b_gate + (size_t)(l * 3 + br) * 1024 + n0 + wn * 64 + i * 16 + 4 * g4);
#pragma unroll
          for (int j2 = 0; j2 < 4; ++j2) {
            gp[i][j2][0] = pack2(sigmoidf_(ga[i][j2][0] + bg[0]), sigmoidf_(ga[i][j2][1] + bg[1]));
            gp[i][j2][1] = pack2(sigmoidf_(ga[i][j2][2] + bg[2]), sigmoidf_(ga[i][j2][3] + bg[3]));
          }
        }
      }
      f32x4 ua[4][4];
#pragma unroll
      for (int i = 0; i < 4; ++i)
#pragma unroll
        for (int j2 = 0; j2 < 4; ++j2) ua[i][j2] = f32x4{0.f, 0.f, 0.f, 0.f};
      const int ucol = (br == 0) ? PC_Q : (br == 1 ? PC_Z : PC_GCV);
      gemm_core<4, false, true>(Wbr + (size_t)(br * 1024 + n0) * 512, 512, P + (size_t)m0 * PS + ucol, PS, 512, ua, lds);
      if (br < 2) gemm_prefetch(Wg + (size_t)((br + 1) * 1024 + n0) * 1024, 1024, H + (size_t)m0 * 1024, 1024, lds);
      else if (u + (int)gridDim.x < total) { int tn2, tm2; decode(u + gridDim.x, tn2, tm2); gemm_prefetch(Wg + (size_t)(tn2 * 128) * 1024, 1024, H + (size_t)tm2 * 128 * 1024, 1024, lds); }
      float rs[4] = {1.f, 1.f, 1.f, 1.f};
      if (br == 1) {
#pragma unroll
        for (int j2 = 0; j2 < 4; ++j2) {
          const float* sp = ssq + (size_t)(m0 + wm * 64 + j2 * 16 + lr) * 8;
          const f32x4 s0 = *(const f32x4*)sp, s1 = *(const f32x4*)(sp + 4);
          const float sm = ((s0[0] + s0[1]) + (s0[2] + s0[3])) + ((s1[0] + s1[1]) + (s1[2] + s1[3]));
          rs[j2] = rsqrtf(sm * (1.f / 512.f) + EPS);
        }
      }
      if (!((KNOCK >> br) & 1)) {
#pragma unroll
        for (int i = 0; i < 4; ++i)
#pragma unroll
          for (int j2 = 0; j2 < 4; ++j2) {
            const float y0 = lo_f(y[i][j2][0]) + lo_f(gp[i][j2][0]) * ua[i][j2][0] * rs[j2];
            const float y1 = hi_f(y[i][j2][0]) + hi_f(gp[i][j2][0]) * ua[i][j2][1] * rs[j2];
            const float y2 = lo_f(y[i][j2][1]) + lo_f(gp[i][j2][1]) * ua[i][j2][2] * rs[j2];
            const float y3 = hi_f(y[i][j2][1]) + hi_f(gp[i][j2][1]) * ua[i][j2][3] * rs[j2];
            y[i][j2][0] = pack2(y0, y1); y[i][j2][1] = pack2(y2, y3);
          }
      }
    }
    {
      char* eb = epi_block_base(lds, w);
#pragma unroll
      for (int i = 0; i < 4; ++i)
#pragma unroll
        for (int j2 = 0; j2 < 4; ++j2) epi_put(eb, i, j2, lr, g4, y[i][j2][0], y[i][j2][1]);
      epi_flush(eb, lane, Y + (size_t)(m0 + wm * 64) * 1024 + n0 + wn * 64, 1024);
    }
  }
}

DI void phaseH(const Params& p, int l, char* lds, bool dry = false) {
  const bfu* Wout = (const bfu*)(ows(p) + OFF_WOUT) + (size_t)l * 1024 * 1024;
  const bfu* Y = (const bfu*)(ows(p) + OFF_ST);
  const float* mod = (const float*)(ows(p) + OFF_MOD);
  float* x1c = (float*)(ows(p) + OFF_X1C);
  const int lane = otid() & 63, w = otid() >> 6, lr = lane & 15, g4 = lane >> 4, wn = w >> 1, wm = w & 1;
  const int nrows = (l == 0) ? NROWS : NLAT;
  const int MT = nrows / 128, MX = MT / 8;
  const int total = MT * 8;
  auto decode = [&](int u, int& tn, int& tm) { const int xcd = u & 7, j = u >> 3; tn = j & 7; tm = xcd * MX + (j >> 3); };
  if ((int)blockIdx.x < total) { int tn, tm; decode(blockIdx.x, tn, tm); gemm_prefetch(Wout + (size_t)tn * 128 * 1024, 1024, Y + (size_t)tm * 128 * 1024, 1024, lds); }
  for (int u = blockIdx.x; u < total; u += gridDim.x) {
    int tn, tm; decode(u, tn, tm);
    const int n0 = tn * 128, m0 = tm * 128;
    f32x4 acc[4][4];
#pragma unroll
    for (int i = 0; i < 4; ++i)
#pragma unroll
      for (int j = 0; j < 4; ++j) acc[i][j] = f32x4{0.f, 0.f, 0.f, 0.f};
    gemm_core<4, false, true, true>(Wout + (size_t)n0 * 1024, 1024, Y + (size_t)m0 * 1024, 1024, 1024, acc, lds);
    if (u + (int)gridDim.x < total) { int tn2, tm2; decode(u + gridDim.x, tn2, tm2); gemm_prefetch(Wout + (size_t)tn2 * 128 * 1024, 1024, Y + (size_t)tm2 * 128 * 1024, 1024, lds); }
    const bool isctx = m0 >= NLAT;
    const int mrow = isctx ? 8 : (m0 >> 12);
    const float* gate = mod + (size_t)(l * 9 + mrow) * 3072 + 2048;
    const float* xres; float* xdst;
    if (!isctx) { xres = (l == 0) ? p.x : p.out; xdst = p.out; }
    else { xres = p.ctx - (size_t)NLAT * 1024; xdst = x1c - (size_t)NLAT * 1024; }
#pragma unroll
    for (int i = 0; i < 4; ++i) {
      const int n = n0 + wn * 64 + i * 16 + 4 * g4;
      const f32x4 gt = *(const f32x4*)(gate + n);
#pragma unroll
      for (int j = 0; j < 4; ++j) {
        const int m = m0 + wm * 64 + j * 16 + lr;
        const f32x4 xr = *(const f32x4*)(xres + (size_t)m * 1024 + n);
        f32x4 o;
#pragma unroll
        for (int r = 0; r < 4; ++r) o[r] = xr[r] + gt[r] * acc[i][j][r];
        if (!dry) *(f32x4*)(xdst + (size_t)m * 1024 + n) = o;
      }
    }
  }
}

DI void phaseFinal(const Params& p) {
  const int lane = otid() & 63;
  const int gw = blockIdx.x * 4 + (otid() >> 6), nw = gridDim.x * 4;
  for (int row = gw; row < NLAT; row += nw) {
    float* src = p.out + (size_t)row * 1024;
    f32x4 v[4];
    float ss = 0.f;
#pragma unroll
    for (int i = 0; i < 4; ++i) { v[i] = ((const f32x4*)src)[i * 64 + lane]; ss += v[i][0] * v[i][0] + v[i][1] * v[i][1] + v[i][2] * v[i][2] + v[i][3] * v[i][3]; }
    ss = wave_sum(ss);
    const float rstd = rsqrtf(ss * (1.f / 1024.f) + EPS);
#pragma unroll
    for (int i = 0; i < 4; ++i) {
      const f32x4 w4 = *(const f32x4*)(p.final_norm_w + (i * 64 + lane) * 4);
      f32x4 o;
#pragma unroll
      for (int r = 0; r < 4; ++r) o[r] = v[i][r] * rstd * w4[r];
      ((f32x4*)src)[i * 64 + lane] = o;
    }
  }
}

typedef const Params __attribute__((address_space(4)))* KArgPtr;
DI Params load_params() {
  KArgPtr q = (KArgPtr)__builtin_amdgcn_kernarg_segment_ptr();
  asm volatile("" : "+s"(q));
  Params r;
  r.x = q->x;
  r.c = q->c;
  r.ctx = q->ctx;
  r.c_ctx = q->c_ctx;
  r.w_mod = q->w_mod;
  r.b_mod = q->b_mod;
  r.norm_w = q->norm_w;
  r.w_in = q->w_in;
  r.q_norm_w = q->q_norm_w;
  r.k_norm_w = q->k_norm_w;
  r.ssd_conv_w = q->ssd_conv_w;
  r.ssd_conv_b = q->ssd_conv_b;
  r.ssd_A_log = q->ssd_A_log;
  r.ssd_dt_bias = q->ssd_dt_bias;
  r.ssd_D = q->ssd_D;
  r.ssd_norm_w = q->ssd_norm_w;
  r.cm_conv_w = q->cm_conv_w;
  r.cm_conv_b = q->cm_conv_b;
  r.cm_ln_w = q->cm_ln_w;
  r.cm_ln_b = q->cm_ln_b;
  r.b_gate = q->b_gate;
  r.w_out = q->w_out;
  r.final_norm_w = q->final_norm_w;
  r.out = q->out;
  r.ws = q->ws;
  r.w_br[0] = q->w_br[0]; r.w_br[1] = q->w_br[1]; r.w_br[2] = q->w_br[2];
  return r;
}

#define XB_TMO      128
#define XB_XCNT(j)  (256  + 64 * (j))
#define XB_XSUB(j)  (1280 + 64 * (j))
#define XB_XGEN(j)  (2304 + 64 * (j))
#define XB_TOP      3328
#define XB_TOPGEN   3392
#define XCD_BAR_WORDS 3456
#define XB_SPIN_CAP (1u << 18)
#define LAS __attribute__((address_space(3)))
DI unsigned xb_ld(unsigned* p)              { return __hip_atomic_load(p, __ATOMIC_RELAXED, __HIP_MEMORY_SCOPE_AGENT); }
DI unsigned xb_add(unsigned* p, unsigned v) { return __hip_atomic_fetch_add(p, v, __ATOMIC_RELAXED, __HIP_MEMORY_SCOPE_AGENT); }
DI unsigned xb_xcc_id() { return (unsigned)__builtin_amdgcn_s_getreg((3 << 11) | 20) & 0xFu; }
#define XB_SPIN(cond, bar) do { unsigned _sp = 0; while (cond) { __builtin_amdgcn_s_sleep(1); \
    if ((++_sp & 255u) == 0u) { if (xb_ld(&(bar)[XB_TMO])) break; if (_sp > XB_SPIN_CAP) { atomicAdd(&(bar)[XB_TMO], 1u); break; } } } } while (0)
struct XcdBarrier { unsigned* bar; unsigned x; volatile LAS unsigned* st; };
DI XcdBarrier xcd_barrier_post(unsigned* bar, volatile LAS unsigned* st) {
  XcdBarrier b; b.bar = bar; b.x = xb_xcc_id(); b.st = st;
  if (threadIdx.x == 0) (void)xb_add(&bar[XB_XCNT(b.x)], 1u);
  return b;
}
DI void xcd_barrier_complete(unsigned* bar, unsigned x, unsigned& nloc, unsigned& nx) {
  const unsigned G = gridDim.x * gridDim.y * gridDim.z;
  unsigned sum, cnt, mine, sp = 0u;
  for (;;) {
    sum = 0u; cnt = 0u; mine = 0u;
#pragma unroll
    for (unsigned j = 0; j < 16; ++j) { const unsigned c = xb_ld(&bar[XB_XCNT(j)]); sum += c; cnt += (c > 0u) ? 1u : 0u; mine = (j == x) ? c : mine; }
    if (sum == G) break;
    __builtin_amdgcn_s_sleep(1);
    if ((++sp & 255u) == 0u) { if (xb_ld(&bar[XB_TMO])) break; if (sp > XB_SPIN_CAP) { atomicAdd(&bar[XB_TMO], 1u); break; } }
  }
  nloc = mine > 0u ? mine : 1u; nx = cnt > 0u ? cnt : 1u;
}
DI void xcd_barrier(const XcdBarrier& b) {
  asm volatile("s_waitcnt vmcnt(0)" ::: "memory");
  __syncthreads();
  if (threadIdx.x == 0) {
    unsigned* bar = b.bar;
    __builtin_amdgcn_s_waitcnt(0);
    unsigned nloc = b.st[0], nx = b.st[1];
    if (nloc == 0u) { xcd_barrier_complete(bar, b.x, nloc, nx); b.st[0] = nloc; b.st[1] = nx; }
    const unsigned old = xb_add(&bar[XB_XSUB(b.x)], 1u);
    const unsigned gen = old / nloc;
    if (old + 1u == (gen + 1u) * nloc) {
      __builtin_amdgcn_fence(__ATOMIC_RELEASE, "agent");
      asm volatile("s_waitcnt vmcnt(0)" ::: "memory");
      const unsigned og = xb_add(&bar[XB_TOP], 1u);
      const unsigned tg = og / nx;
      if (og + 1u == (tg + 1u) * nx) xb_add(&bar[XB_TOPGEN], 1u);
      else XB_SPIN(xb_ld(&bar[XB_TOPGEN]) == tg, bar);
      __builtin_amdgcn_fence(__ATOMIC_ACQUIRE, "agent");
      xb_add(&bar[XB_XGEN(b.x)], 1u);
      asm volatile("s_waitcnt vmcnt(0)" ::: "memory");
    } else {
      XB_SPIN(xb_ld(&bar[XB_XGEN(b.x)]) == gen, bar);
      __builtin_amdgcn_fence(__ATOMIC_ACQUIRE, "agent");
      asm volatile("s_waitcnt vmcnt(0)" ::: "memory");
    }
  }
  __syncthreads();
}

#define lp load_params()
__global__ void __launch_bounds__(256, 2) hybrid_megakernel(Params p_unused) {
  __shared__ __attribute__((aligned(16))) char lds[65536];
  __shared__ uint4 xb_words;
  cg::grid_group grid = cg::this_grid();
  if (threadIdx.x == 0) xb_words = make_uint4(0u, 0u, 0u, 0u);
  __syncthreads();
  if (blockIdx.x == 0) {
    unsigned* bw = (unsigned*)(load_params().ws + OFF_BAR);
    for (int i = threadIdx.x; i < XCD_BAR_WORDS; i += 256) bw[i] = 0u;
  }
  phase0(lp, lds);
  grid.sync();
  const XcdBarrier xb = xcd_barrier_post((unsigned*)(load_params().ws + OFF_BAR), (volatile LAS unsigned*)&xb_words);
#pragma unroll 1
  for (int l = 0; l < 2; ++l) {
    phaseA(lp, l);
    xcd_barrier(xb);
    if (REP == 8) { phaseA(lp, l); xcd_barrier(xb); phase0(lp, lds); xcd_barrier(xb); }
    phaseB(lp, l, lds);
    xcd_barrier(xb);
    if (REP == 1) { phaseB(lp, l, lds); xcd_barrier(xb); }
    if (REP == 5) { phaseC1(lp, l, lds, lp.out != nullptr); xcd_barrier(xb); }
    phaseC1(lp, l, lds);
    xcd_barrier(xb);
    if (REP == 3) { phaseC2(lp, l, lds, lp.out == nullptr ? false : true); xcd_barrier(xb); }
    phaseC2(lp, l, lds);
    xcd_barrier(xb);
    if (REP == 7) { for (int u = blockIdx.x; u < (NROWS / 128) * 8; u += gridDim.x) sloc_unit(lp, l, u, lds); xcd_barrier(xb); }
    if (REP == 9) { for (int i = 0; i < 10; ++i) xcd_barrier(xb); }
    for (int u = blockIdx.x; u < (NROWS / 128) * 8; u += gridDim.x) sloc_unit(lp, l, u, lds);
    xcd_barrier(xb);
    phaseD2(lp);
    xcd_barrier(xb);
    if (REP == 6) {
      const int ny = ((l == 0) ? NROWS / 128 : NLAT / 128) * 8;
      for (int u = blockIdx.x; u < ny; u += gridDim.x) ssdy_unit(lp, l, u, lds, lp.out != nullptr);
      xcd_barrier(xb);
    }
    {
      const int ny = ((l == 0) ? NROWS / 128 : NLAT / 128) * 8;
      for (int u = blockIdx.x; u < ny; u += gridDim.x) ssdy_unit(lp, l, u, lds);
    }
    xcd_barrier(xb);
    phaseG(lp, l, lds);
    xcd_barrier(xb);
    if (REP == 2) { phaseG(lp, l, lds); xcd_barrier(xb); }
    if (REP == 4) { phaseH(lp, l, lds, lp.out != nullptr); xcd_barrier(xb); }
    phaseH(lp, l, lds);
    xcd_barrier(xb);
  }
  phaseFinal(lp);
}

#undef lp
extern "C" void kernel_launch(void* const* d_in, const int* in_sizes, int n_in,
                              void* d_out, int out_size, void* d_ws, size_t ws_size,
                              hipStream_t stream) {
  static int grid_blocks = 0;
  if (!grid_blocks) {
    int dev = 0, cus = 0, per_cu = 0;
    (void)hipGetDevice(&dev);
    (void)hipDeviceGetAttribute(&cus, hipDeviceAttributeMultiprocessorCount, dev);
    (void)hipOccupancyMaxActiveBlocksPerMultiprocessor(&per_cu, hybrid_megakernel, 256, 0);
    if (per_cu > 2) per_cu = 2;
    if (per_cu < 1) per_cu = 1;
    grid_blocks = cus * per_cu;
  }
  Params p{};
  const float* const* in = (const float* const*)d_in;
  p.x = in[0]; p.c = in[1]; p.ctx = in[2]; p.c_ctx = in[3]; p.w_mod = in[4]; p.b_mod = in[5]; p.norm_w = in[6];
  p.w_in = in[7]; p.q_norm_w = in[8]; p.k_norm_w = in[9]; p.ssd_conv_w = in[10]; p.ssd_conv_b = in[11];
  p.ssd_A_log = in[12]; p.ssd_dt_bias = in[13]; p.ssd_D = in[14]; p.ssd_norm_w = in[15];
  p.cm_conv_w = in[16]; p.cm_conv_b = in[17]; p.cm_ln_w = in[18]; p.cm_ln_b = in[19];
  p.w_br[0] = in[20]; p.w_br[1] = in[21]; p.w_br[2] = in[22];
  p.b_gate = in[23]; p.w_out = in[24]; p.final_norm_w = in[25];
  p.out = (float*)d_out;
  p.ws = (char*)d_ws;
  void* args[] = {&p};
  (void)hipLaunchCooperativeKernel((void*)hybrid_megakernel, dim3(grid_blocks), dim3(256), args, 0, stream);
}
```
